# Optimizing an MI355X kernel written in HIP

```python
import math
import jax, jax.numpy as jnp
from jax import lax
import numpy as np

D_MODEL = 1024
BATCH = 8
SEQ = 4096
DEPTH = 2

PLE_DIM = 256
N_BRANCHES = 4
BRANCH_WIDTH = D_MODEL // 4
HEAD_DIM = 64
N_HEADS = BRANCH_WIDTH // HEAD_DIM
S5_GROUP_CH = 16
S5_GROUPS = BRANCH_WIDTH // S5_GROUP_CH
S5_STATE = 64
RWKV_DECAY_LORA = 64
RWKV_AAA_LORA = 64
RWKV_GATE_LORA = 128
RWKV_PROJ = 3 * BRANCH_WIDTH + RWKV_DECAY_LORA + RWKV_AAA_LORA + RWKV_GATE_LORA
D_FF = 4 * D_MODEL
QBLOCK = 128
LN_EPS = 1e-5
GN_EPS = 64e-5
DEEPNORM_ALPHA = (2 * DEPTH) ** 0.25
DEEPNORM_BETA = (8 * DEPTH) ** -0.25
IN_SPLIT_SIZES = (BRANCH_WIDTH, BRANCH_WIDTH, BRANCH_WIDTH, BRANCH_WIDTH, N_HEADS, RWKV_PROJ,
                  BRANCH_WIDTH, BRANCH_WIDTH, BRANCH_WIDTH, N_BRANCHES * D_MODEL)
D_IN = sum(IN_SPLIT_SIZES)
RWKV_SPLIT_SIZES = (BRANCH_WIDTH, BRANCH_WIDTH, BRANCH_WIDTH, RWKV_DECAY_LORA, RWKV_AAA_LORA, RWKV_GATE_LORA)

kernel_name = 'hybrid_s5_fox_rwkv7_stickbreaking_deepnorm'


def _split(t, sizes):
    points = np.cumsum(sizes)[:-1].tolist()
    return jnp.split(t, points, axis=-1)


def _layer_norm(t, g, b):
    tf = t.astype(jnp.float32)
    mu = jnp.mean(tf, axis=-1, keepdims=True)
    var = jnp.mean(jnp.square(tf - mu), axis=-1, keepdims=True)
    return ((tf - mu) * lax.rsqrt(var + LN_EPS) * g + b).astype(t.dtype)


def _heads(t):
    return t.reshape(t.shape[:-1] + (N_HEADS, HEAD_DIM))


def _query_blocks(t):
    b, s = t.shape[:2]
    t = t.reshape((b, s // QBLOCK, QBLOCK) + t.shape[2:])
    return jnp.moveaxis(t, 1, 0)


def _merge_blocks(t):
    t = jnp.moveaxis(t, 0, 1)
    return t.reshape((t.shape[0], t.shape[1] * t.shape[2]) + t.shape[3:])


def _s5_mixer(u, lam_re, lam_im, log_dt, b_re, b_im, c_re, c_im, d, glu_w, glu_b):
    bsz, s = u.shape[:2]
    f32 = jnp.float32
    ug = u.astype(f32).reshape(bsz, s, S5_GROUPS, S5_GROUP_CH)
    dt = jnp.exp(log_dt.astype(f32))[:, None]
    lam_re = lam_re.astype(f32)
    lam_im = lam_im.astype(f32)
    mag = jnp.exp(lam_re * dt)
    ang = lam_im * dt
    lb_re = mag * jnp.cos(ang)
    lb_im = mag * jnp.sin(ang)
    den = jnp.square(lam_re) + jnp.square(lam_im)
    nr = lb_re - 1.0
    f_re = (nr * lam_re + lb_im * lam_im) / den
    f_im = (lb_im * lam_re - nr * lam_im) / den
    bb_re = f_re[..., None] * b_re - f_im[..., None] * b_im
    bb_im = f_re[..., None] * b_im + f_im[..., None] * b_re
    bu_re = jnp.einsum('bsgh,gph->bsgp', ug, bb_re)
    bu_im = jnp.einsum('bsgh,gph->bsgp', ug, bb_im)
    a_re = jnp.broadcast_to(lb_re, bu_re.shape)
    a_im = jnp.broadcast_to(lb_im, bu_im.shape)

    def combine(e1, e2):
        a1r, a1i, b1r, b1i = e1
        a2r, a2i, b2r, b2i = e2
        return (a2r * a1r - a2i * a1i,
                a2r * a1i + a2i * a1r,
                a2r * b1r - a2i * b1i + b2r,
                a2r * b1i + a2i * b1r + b2i)

    _, _, x_re, x_im = lax.associative_scan(combine, (a_re, a_im, bu_re, bu_im), axis=1)
    y = (jnp.einsum('bsgp,ghp->bsgh', x_re, c_re) - jnp.einsum('bsgp,ghp->bsgh', x_im, c_im)
         + d * ug)
    y = jax.nn.gelu(y.reshape(bsz, s, BRANCH_WIDTH))
    y = y * jax.nn.sigmoid(y @ glu_w + glu_b)
    return y.astype(u.dtype)


def _forgetting_attention(q, k, v, f_logit):
    s = q.shape[1]
    f32 = jnp.float32
    scale = HEAD_DIM ** -0.5
    c = jnp.cumsum(jax.nn.log_sigmoid(f_logit.astype(f32)), axis=1)
    kf = k.astype(f32)
    vf = v.astype(f32)
    c_key = jnp.moveaxis(c, 1, 2)
    kpos = jnp.arange(s)

    def block(args):
        i, qb, cb = args
        qpos = i * QBLOCK + jnp.arange(QBLOCK)
        logits = jnp.einsum('bqhd,bkhd->bhqk', qb.astype(f32), kf) * scale
        logits = logits + jnp.moveaxis(cb, 1, 2)[..., None] - c_key[:, :, None, :]
        logits = jnp.where(kpos[None, :] <= qpos[:, None], logits, -jnp.inf)
        probs = jax.nn.softmax(logits, axis=-1)
        return jnp.einsum('bhqk,bkhd->bqhd', probs, vf)

    out = lax.map(block, (jnp.arange(s // QBLOCK), _query_blocks(q), _query_blocks(c)))
    return _merge_blocks(out).astype(q.dtype)


def _stick_breaking_attention(q, k, v):
    s = q.shape[1]
    f32 = jnp.float32
    scale = HEAD_DIM ** -0.5
    kf = k.astype(f32)
    vf = v.astype(f32)
    kpos = jnp.arange(s)

    def block(args):
        i, qb = args
        qpos = i * QBLOCK + jnp.arange(QBLOCK)
        z = jnp.einsum('bqhd,bkhd->bhqk', qb.astype(f32), kf) * scale
        mask = kpos[None, :] < qpos[:, None]
        log_rest = jnp.where(mask, jax.nn.log_sigmoid(-z), 0.0)
        between = lax.cumsum(log_rest, axis=3, reverse=True) - log_rest
        weights = jnp.where(mask, jnp.exp(jax.nn.log_sigmoid(z) + between), 0.0)
        return jnp.einsum('bhqk,bkhd->bqhd', weights, vf)

    out = lax.map(block, (jnp.arange(s // QBLOCK), _query_blocks(q)))
    return _merge_blocks(out).astype(q.dtype)


def _rwkv7_time_mix(proj, mu, w0, w2, a0, a2, g2, k_k, k_a, r_k, lnx_g, lnx_b):
    bsz = proj.shape[0]
    f32 = jnp.float32
    prev = jnp.pad(proj, ((0, 0), (1, 0), (0, 0)))[:, :-1]
    xs = proj + (prev - proj) * mu
    r, k, v, w1, a1, g1 = _split(xs, RWKV_SPLIT_SIZES)
    w = -jax.nn.softplus(-(w0 + jnp.tanh(w1) @ w2)) - 0.5
    decay = jnp.exp(-jnp.exp(w.astype(f32)))
    a = jax.nn.sigmoid(a0 + a1 @ a2)
    g = jax.nn.sigmoid(g1) @ g2
    kk = _heads((k * k_k).astype(f32))
    kk = kk / jnp.maximum(jnp.sqrt(jnp.sum(jnp.square(kk), axis=-1, keepdims=True)), 1e-12)
    k = k * (1.0 + (a - 1.0) * k_a)
    rh, kh, vh, ah, dh = [_heads(t.astype(f32)) for t in (r, k, v, a, decay)]

    def step(state, inp):
        r_t, w_t, k_t, v_t, kk_t, a_t = inp
        sa = jnp.einsum('bhvk,bhk->bhv', state, -kk_t)
        state = (state * w_t[:, :, None, :] + sa[..., None] * (kk_t * a_t)[:, :, None, :]
                 + v_t[..., None] * k_t[:, :, None, :])
        return state, jnp.einsum('bhvk,bhk->bhv', state, r_t)

    tm = lambda t: jnp.moveaxis(t, 1, 0)
    init = jnp.zeros((bsz, N_HEADS, HEAD_DIM, HEAD_DIM), f32)
    _, y = lax.scan(step, init, (tm(rh), tm(dh), tm(kh), tm(vh), tm(kk), tm(ah)))
    y = jnp.moveaxis(y, 0, 1)
    ym = jnp.mean(y, axis=-1, keepdims=True)
    yv = jnp.mean(jnp.square(y - ym), axis=-1, keepdims=True)
    yn = (y - ym) * lax.rsqrt(yv + GN_EPS)
    yn = yn.reshape(y.shape[:2] + (BRANCH_WIDTH,)) * lnx_g + lnx_b
    bonus = (jnp.sum(rh * kh * r_k, axis=-1, keepdims=True) * vh).reshape(yn.shape)
    return ((yn + bonus) * g).astype(proj.dtype)


def setup_inputs(seed: int = 0) -> dict:
    key = jax.random.key(seed)
    keys = iter(jax.random.split(key, 40))
    f32 = jnp.float32
    nrm = lambda shape, scale: scale * jax.random.normal(next(keys), shape, f32)
    uni = lambda shape, lo, hi: jax.random.uniform(next(keys), shape, f32, minval=lo, maxval=hi)
    L, G, P, H16, BW = DEPTH, S5_GROUPS, S5_STATE, S5_GROUP_CH, BRANCH_WIDTH
    beta = DEEPNORM_BETA
    return {
        'x': nrm((BATCH, SEQ, D_MODEL), 1.0),
        'p': nrm((DEPTH, BATCH, SEQ, PLE_DIM), 1.0),
        'w_in': nrm((L, D_MODEL, D_IN), D_MODEL ** -0.5),
        's5_lambda_re': -0.5 + nrm((L, G, P), 0.01),
        's5_lambda_im': jnp.broadcast_to(math.pi * jnp.arange(P, dtype=f32), (L, G, P)),
        's5_log_dt': uni((L, G), math.log(1e-3), math.log(1e-1)),
        's5_b_re': nrm((L, G, P, H16), (2.0 * H16) ** -0.5),
        's5_b_im': nrm((L, G, P, H16), (2.0 * H16) ** -0.5),
        's5_c_re': nrm((L, G, H16, P), (2.0 * P) ** -0.5),
        's5_c_im': nrm((L, G, H16, P), (2.0 * P) ** -0.5),
        's5_d': nrm((L, G, H16), 1.0),
        's5_glu_w': nrm((L, BW, BW), BW ** -0.5),
        's5_glu_b': nrm((L, BW), 0.01),
        'fox_f_bias': 3.0 + nrm((L, N_HEADS), 0.5),
        'rwkv_mu': uni((L, RWKV_PROJ), 0.0, 1.0),
        'rwkv_w0': uni((L, BW), -6.0, 1.0),
        'rwkv_w2': nrm((L, RWKV_DECAY_LORA, BW), 0.3 * RWKV_DECAY_LORA ** -0.5),
        'rwkv_a0': nrm((L, BW), 0.1),
        'rwkv_a2': nrm((L, RWKV_AAA_LORA, BW), 0.3 * RWKV_AAA_LORA ** -0.5),
        'rwkv_g2': nrm((L, RWKV_GATE_LORA, BW), RWKV_GATE_LORA ** -0.5),
        'rwkv_k_k': 0.85 + nrm((L, BW), 0.05),
        'rwkv_k_a': 1.0 + nrm((L, BW), 0.05),
        'rwkv_r_k': nrm((L, N_HEADS, HEAD_DIM), 0.1),
        'rwkv_lnx_g': 1.0 + nrm((L, BW), 0.01),
        'rwkv_lnx_b': nrm((L, BW), 0.01),
        'w_branch': nrm((L, N_BRANCHES, BW, D_MODEL), beta * BW ** -0.5),
        'w_out': nrm((L, D_MODEL, D_MODEL), beta * D_MODEL ** -0.5),
        'ln1_g': 1.0 + nrm((L, D_MODEL), 0.01),
        'ln1_b': nrm((L, D_MODEL), 0.01),
        'mlp_w1': nrm((L, D_MODEL, D_FF), beta * D_MODEL ** -0.5),
        'mlp_w2': nrm((L, D_FF, D_MODEL), beta * D_FF ** -0.5),
        'ple_w': nrm((L, PLE_DIM, D_MODEL), beta * PLE_DIM ** -0.5),
        'ple_gate_w': nrm((L, D_MODEL, D_MODEL), D_MODEL ** -0.5),
        'ln2_g': 1.0 + nrm((L, D_MODEL), 0.01),
        'ln2_b': nrm((L, D_MODEL), 0.01),
    }


def reference(x, p, w_in, s5_lambda_re, s5_lambda_im, s5_log_dt, s5_b_re, s5_b_im, s5_c_re, s5_c_im,
              s5_d, s5_glu_w, s5_glu_b, fox_f_bias, rwkv_mu, rwkv_w0, rwkv_w2, rwkv_a0, rwkv_a2, rwkv_g2,
              rwkv_k_k, rwkv_k_a, rwkv_r_k, rwkv_lnx_g, rwkv_lnx_b, w_branch, w_out, ln1_g, ln1_b,
              mlp_w1, mlp_w2, ple_w, ple_gate_w, ln2_g, ln2_b):
    bsz, s, _ = x.shape
    h = x
    for i in range(DEPTH):
        proj = h @ w_in[i]
        (s5_u, fq, fk, fv, ff, rw, sq, sk, sv, gates) = _split(proj, IN_SPLIT_SIZES)
        y_s5 = _s5_mixer(s5_u, s5_lambda_re[i], s5_lambda_im[i], s5_log_dt[i], s5_b_re[i], s5_b_im[i],
                         s5_c_re[i], s5_c_im[i], s5_d[i], s5_glu_w[i], s5_glu_b[i])
        y_fox = _forgetting_attention(_heads(fq), _heads(fk), _heads(fv),
                                      ff + fox_f_bias[i]).reshape(bsz, s, BRANCH_WIDTH)
        y_rwkv = _rwkv7_time_mix(rw, rwkv_mu[i], rwkv_w0[i], rwkv_w2[i], rwkv_a0[i], rwkv_a2[i],
                                 rwkv_g2[i], rwkv_k_k[i], rwkv_k_a[i], rwkv_r_k[i],
                                 rwkv_lnx_g[i], rwkv_lnx_b[i])
        y_sb = _stick_breaking_attention(_heads(sq), _heads(sk), _heads(sv)).reshape(bsz, s, BRANCH_WIDTH)
        gates = gates.reshape(bsz, s, N_BRANCHES, D_MODEL)
        branches = (y_s5, y_fox, y_rwkv, y_sb)
        merged = sum(jax.nn.sigmoid(gates[:, :, n]) * (branches[n] @ w_branch[i, n])
                     for n in range(N_BRANCHES))
        h = _layer_norm(DEEPNORM_ALPHA * h + merged @ w_out[i], ln1_g[i], ln1_b[i])
        ffn = jnp.square(jax.nn.relu(h @ mlp_w1[i])) @ mlp_w2[i]
        ple = jax.nn.sigmoid(h @ ple_gate_w[i]) * (p[i] @ ple_w[i])
        h = _layer_norm(DEEPNORM_ALPHA * h + ffn + ple, ln2_g[i], ln2_b[i])
    return h
```

```cpp
#include <hip/hip_runtime.h>
#include <hip/hip_cooperative_groups.h>
#include <cstdio>
#include <cstdint>
namespace cg = cooperative_groups;

#define LAS __attribute__((address_space(3)))
typedef unsigned short bf16_t;
typedef short bf16x8 __attribute__((ext_vector_type(8)));
typedef short s16x4 __attribute__((ext_vector_type(4)));
typedef float f32x4 __attribute__((ext_vector_type(4)));
typedef float f32x2 __attribute__((ext_vector_type(2)));
typedef float f32x16 __attribute__((ext_vector_type(16)));
typedef unsigned u32x4 __attribute__((ext_vector_type(4)));
typedef unsigned u32x2 __attribute__((ext_vector_type(2)));

constexpr int DM = 1024, NB = 8, SEQ = 4096, MTOK = NB * SEQ, DEPTH = 2, PLE = 256, BW = 256, DFF = 4096, DIN = 6916;
constexpr int PSLD = 2816;
constexpr float LN_EPS = 1e-5f, GN_EPS = 64e-5f;
constexpr float ALPHA = 1.4142135623730951f;
enum { IX = 0, IP, IW_IN, IS5_LRE, IS5_LIM, IS5_LDT, IS5_BRE, IS5_BIM, IS5_CRE, IS5_CIM, IS5_D, IS5_GLUW, IS5_GLUB, IFOX_B, IRW_MU, IRW_W0, IRW_W2, IRW_A0, IRW_A2,
       IRW_G2, IRW_KK, IRW_KA, IRW_RK, IRW_LNG, IRW_LNB, IW_BR, IW_OUT, ILN1G, ILN1B, IW1, IW2, IPLE_W, IPLE_G, ILN2G, ILN2B, NIN };

constexpr size_t SZ_M1024_BF = (size_t)MTOK * 1024 * 2;
constexpr size_t OFF_YC = 0;
constexpr size_t OFF_PS = OFF_YC + SZ_M1024_BF;
constexpr size_t SZ_PS = (size_t)MTOK * PSLD * 2;
constexpr size_t OFF_RW = OFF_PS + SZ_PS;
constexpr size_t SZ_M256_BF = (size_t)MTOK * 256 * 2;
constexpr size_t OFF_RW_DEC = OFF_RW;
constexpr size_t OFF_RW_R = OFF_RW_DEC + 2 * SZ_M256_BF;
constexpr size_t OFF_RW_K = OFF_RW_R + SZ_M256_BF;
constexpr size_t OFF_RW_V = OFF_RW_K + SZ_M256_BF;
constexpr size_t OFF_RW_KK = OFF_RW_V + SZ_M256_BF;
constexpr size_t OFF_RW_B = OFF_RW_KK + SZ_M256_BF;
constexpr size_t OFF_RW_G = OFF_RW_B + SZ_M256_BF;
constexpr size_t OFF_RW_END = OFF_RW_G + SZ_M256_BF;
constexpr size_t OFF_U = OFF_PS;
constexpr size_t OFF_G5S = OFF_U + (size_t)MTOK * 4096 * 2;
constexpr size_t OFF_G2S = OFF_PS;
constexpr size_t OFF_MG = OFF_RW;
constexpr size_t OFF_HB = OFF_RW_END;
constexpr size_t OFF_WT = OFF_HB + SZ_M1024_BF;
constexpr size_t WT_IN = 0;
constexpr size_t WT_BR = WT_IN + (size_t)DIN * 1024;
constexpr size_t WT_OUT = WT_BR + 4 * 1024 * 256;
constexpr size_t WT_W1 = WT_OUT + 1024 * 1024;
constexpr size_t WT_W2 = WT_W1 + 4096 * 1024;
constexpr size_t WT_PL = WT_W2 + 4096 * 1024;
constexpr size_t WT_PG = WT_PL + 1024 * 256;
constexpr size_t WT_GLU = WT_PG + 1024 * 1024;
constexpr size_t WT_RW2 = WT_GLU + 256 * 256;
constexpr size_t WT_RA2 = WT_RW2 + 256 * 64;
constexpr size_t WT_RG2 = WT_RA2 + 256 * 64;
constexpr size_t WT_END = WT_RG2 + 256 * 128;
constexpr size_t OFF_FL = OFF_WT + WT_END * 2;
constexpr size_t OFF_CL = OFF_FL + (size_t)MTOK * 4 * 4;
constexpr size_t OFF_E256 = OFF_CL + (size_t)MTOK * 4 * 4;
constexpr size_t OFF_L32 = OFF_E256 + (size_t)NB * 16 * 16 * 64 * 8;
constexpr size_t OFF_CTR = OFF_L32 + (size_t)NB * 128 * 16 * 64 * 8;
constexpr size_t OFF_BAR = OFF_CTR + 4096;
constexpr size_t OFF_STAT = OFF_BAR + 16384;
constexpr size_t WS_END = OFF_STAT + (size_t)MTOK * 8;
static_assert(OFF_G5S + (size_t)256 * 131072 <= OFF_RW_END, "G5 scratch must fit in the dead rwkv region");
static_assert(WS_END <= (size_t)536870912, "workspace map exceeds 512 MiB");

constexpr int LDS_BYTES = 131072 + 16384;

typedef __bf16 bf16x2_t __attribute__((ext_vector_type(2)));
__device__ __forceinline__ unsigned pk2(float lo, float hi) { f32x2 v; v[0] = lo; v[1] = hi; bf16x2_t r = __builtin_convertvector(v, bf16x2_t); return __builtin_bit_cast(unsigned, r); }
__device__ __forceinline__ float bflo(unsigned u) { return __uint_as_float(u << 16); }
__device__ __forceinline__ float bfhi(unsigned u) { return __uint_as_float(u & 0xffff0000u); }
__device__ __forceinline__ float bf1(bf16_t u) { return __uint_as_float(((unsigned)u) << 16); }
__device__ __forceinline__ float sigm(float x) { return __builtin_amdgcn_rcpf(1.f + __expf(-x)); }
__device__ __forceinline__ float lane_get(float v, int src_lane) { return __builtin_bit_cast(float, __builtin_amdgcn_ds_bpermute(src_lane << 2, __builtin_bit_cast(int, v))); }
__device__ __forceinline__ float wave_sum(float v, int lane) {
#pragma unroll
    for (int o = 1; o < 64; o <<= 1) v += lane_get(v, lane ^ o);
    return v;
}
__device__ __forceinline__ float rowsum16(float x) {
    x += __builtin_bit_cast(float, __builtin_amdgcn_update_dpp(0, __builtin_bit_cast(int, x), 0x128, 0xf, 0xf, false));
    x += __builtin_bit_cast(float, __builtin_amdgcn_update_dpp(0, __builtin_bit_cast(int, x), 0x124, 0xf, 0xf, false));
    x += __builtin_bit_cast(float, __builtin_amdgcn_update_dpp(0, __builtin_bit_cast(int, x), 0x122, 0xf, 0xf, false));
    x += __builtin_bit_cast(float, __builtin_amdgcn_update_dpp(0, __builtin_bit_cast(int, x), 0x121, 0xf, 0xf, false));
    return x;
}
__device__ __forceinline__ void rowsum16x2(float& a, float& b) {
#define DPP_ROR_(x, c) __builtin_bit_cast(float, __builtin_amdgcn_update_dpp(0, __builtin_bit_cast(int, x), c, 0xf, 0xf, false))
    float ta = DPP_ROR_(a, 0x128), tb = DPP_ROR_(b, 0x128); a += ta; b += tb;
    ta = DPP_ROR_(a, 0x124); tb = DPP_ROR_(b, 0x124); a += ta; b += tb;
    ta = DPP_ROR_(a, 0x122); tb = DPP_ROR_(b, 0x122); a += ta; b += tb;
    ta = DPP_ROR_(a, 0x121); tb = DPP_ROR_(b, 0x121); a += ta; b += tb;
#undef DPP_ROR_
}
__device__ __forceinline__ float other_half(float v, int hi) {
    auto rr = __builtin_amdgcn_permlane32_swap(__float_as_uint(v), __float_as_uint(v), false, false);
    return __uint_as_float(hi ? rr[0] : rr[1]);
}

namespace pg8 {
constexpr int BM = 256, BK = 64, HALF = 128, HTB = HALF * BK * 2, STAGE_BYTES = 8 * HTB, NXCD = 8, WGM = 8;
__device__ __forceinline__ int lds_byte(int r, int c) { const int st = (r >> 4) * 2 + (c >> 5), rr = r & 15, cc = c & 31, ob = rr * 64 + cc * 2; return st * 1024 + (ob ^ (((ob >> 9) & 1) << 5)); }
__device__ __forceinline__ void stage_rc(int b, int& R, int& C) { const int st = b / 1024, sb = b % 1024, swz = sb ^ (((sb >> 9) & 1) << 5); R = (st >> 1) * 16 + swz / 64; C = (st & 1) * 32 + (swz % 64) / 2; }
__device__ __forceinline__ int perm32(int rho) { const int n = rho >> 4, i = rho & 15; return 8 * (i >> 2) + 4 * n + (i & 3); }

struct GUnit { const char* A; const char* B; unsigned lda, ldb; int nt, pm, pn, kind; };

__device__ __forceinline__ void tile_of(int L, int nM, int nN, int& pm, int& pn) {
    const int nwg = nM * nN; int wgid = L;
    { const int q = nwg / NXCD, r = nwg % NXCD, xcd = wgid % NXCD, off = wgid / NXCD; wgid = (xcd < r ? xcd * (q + 1) : r * (q + 1) + (xcd - r) * q) + off; }
    const int nig = WGM * nN, gid = wgid / nig, fm = gid * WGM, gsz = (nM - fm) < WGM ? (nM - fm) : WGM;
    pm = fm + ((wgid % nig) % gsz); pn = (wgid % nig) / gsz;
}

template <class Sched, class Epi>
__device__ __forceinline__ void gemm_phase(LAS unsigned char* lds, const Sched& S, const Epi& E, const int tid) {
    const int wid = __builtin_amdgcn_readfirstlane(tid >> 6), lane = tid & 63, wr = wid >> 2, wc = wid & 3, fr = lane & 15, fq = lane >> 4;
    int sR0, sC0, sR1, sC1; stage_rc(tid * 16, sR0, sC0); stage_rc(tid * 16 + 8192, sR1, sC1);
    const int sRb0 = (sR0 & ~31) + perm32(sR0 & 31), sRb1 = (sR1 & ~31) + perm32(sR1 & 31);
    sC0 *= 2; sC1 *= 2;
    const unsigned ldsw = (unsigned)wid * 1024u;
    const int aoff = lds_byte(wr * 64 + fr, fq * 8), boff = lds_byte(wc * 32 + fr, fq * 8);
#define PG8_SA(b, h) (((b) * 2 + (h)) * HTB)
#define PG8_SB(b, h) ((4 + (b) * 2 + (h)) * HTB)
#define PG8_STAGE_A(bufoff, gbase, ld) do { \
        __builtin_amdgcn_global_load_lds((const unsigned*)((const char*)(gbase) + (unsigned)(sR0 * (ld) + sC0)), (LAS unsigned*)(lds + (bufoff) + ldsw), 16, 0, 0); \
        __builtin_amdgcn_global_load_lds((const unsigned*)((const char*)(gbase) + (unsigned)(sR1 * (ld) + sC1)), (LAS unsigned*)(lds + (bufoff) + ldsw + 8192), 16, 0, 0); } while (0)
#define PG8_STAGE_B(bufoff, gbase, ld) do { \
        __builtin_amdgcn_global_load_lds((const unsigned*)((const char*)(gbase) + (unsigned)(sRb0 * (ld) + sC0)), (LAS unsigned*)(lds + (bufoff) + ldsw), 16, 0, 0); \
        __builtin_amdgcn_global_load_lds((const unsigned*)((const char*)(gbase) + (unsigned)(sRb1 * (ld) + sC1)), (LAS unsigned*)(lds + (bufoff) + ldsw + 8192), 16, 0, 0); } while (0)
#define PG8_LDA(dst, b, h) do { _Pragma("unroll") for (int m = 0; m < 4; ++m) _Pragma("unroll") for (int k = 0; k < 2; ++k) dst[m][k] = *(const LAS bf16x8*)(lds + PG8_SA(b, h) + aoff + m * 2048 + k * 1024); } while (0)
#define PG8_LDB(dst, b, h) do { _Pragma("unroll") for (int n = 0; n < 2; ++n) _Pragma("unroll") for (int k = 0; k < 2; ++k) dst[n][k] = *(const LAS bf16x8*)(lds + PG8_SB(b, h) + boff + n * 2048 + k * 1024); } while (0)
#define PG8_MMA(ai, bj, At, Bt) do { __builtin_amdgcn_s_setprio(1); _Pragma("unroll") for (int m = 0; m < 4; ++m) _Pragma("unroll") for (int n = 0; n < 2; ++n) _Pragma("unroll") for (int k = 0; k < 2; ++k) \
        acc[ai][bj][m][n] = __builtin_amdgcn_mfma_f32_16x16x32_bf16(Bt[n][k], At[m][k], acc[ai][bj][m][n], 0, 0, 0); __builtin_amdgcn_s_setprio(0); } while (0)
#define PG8_WAIT_V(n) asm volatile("s_waitcnt vmcnt(" #n ")" ::: "memory")
#define PG8_WAIT_L(n) asm volatile("s_waitcnt lgkmcnt(" #n ")" ::: "memory")
#define PG8_BAR __builtin_amdgcn_s_barrier()
#define PG8_SCHED __builtin_amdgcn_sched_barrier(0)
    GUnit cur, nxt; int ui = 0;
    if (!S.next(0, cur)) return;
    f32x4 acc[2][2][4][2];
#pragma unroll
    for (int a = 0; a < 2; ++a)
#pragma unroll
        for (int b = 0; b < 2; ++b)
#pragma unroll
            for (int m = 0; m < 4; ++m)
#pragma unroll
                for (int n = 0; n < 2; ++n) acc[a][b][m][n] = (f32x4){0.f, 0.f, 0.f, 0.f};
    bf16x8 At[4][2], B0[2][2], B1[2][2];
    const char* cA = cur.A; const char* cB = cur.B; unsigned clda = cur.lda, cldb = cur.ldb;
    PG8_STAGE_B(PG8_SB(0, 0), cB, cldb); PG8_STAGE_A(PG8_SA(0, 0), cA, clda); PG8_STAGE_B(PG8_SB(0, 1), cB + (size_t)HALF * cldb, cldb); PG8_STAGE_A(PG8_SA(0, 1), cA + (size_t)HALF * clda, clda);
    if (wr == 1) PG8_BAR;
    PG8_WAIT_V(4); PG8_BAR;
    PG8_STAGE_B(PG8_SB(1, 0), cB + 128, cldb); PG8_STAGE_A(PG8_SA(1, 0), cA + 128, clda); PG8_STAGE_B(PG8_SB(1, 1), cB + (size_t)HALF * cldb + 128, cldb);
    PG8_WAIT_V(6); PG8_BAR;
    for (;;) {
        const bool has_next = S.next(ui + 1, nxt);
        const char* nA = has_next ? nxt.A : cA; const char* nB = has_next ? nxt.B : cB;
        const unsigned nlda = has_next ? nxt.lda : clda, nldb = has_next ? nxt.ldb : cldb;
        const int nt = cur.nt;
        for (int t = 0; t < nt; t += 2) {
            const bool last = (t == nt - 2);
            const char* a1 = cA + (size_t)(t + 1) * 128;
            const char* a2 = last ? nA : cA + (size_t)(t + 2) * 128; const char* b2 = last ? nB : cB + (size_t)(t + 2) * 128;
            const char* a3 = a2 + 128; const char* b3 = b2 + 128;
            const unsigned lda2 = last ? nlda : clda, ldb2 = last ? nldb : cldb;
            PG8_LDB(B0, 0, 0); PG8_SCHED; PG8_LDA(At, 0, 0); PG8_STAGE_A(PG8_SA(1, 1), a1 + (size_t)HALF * clda, clda);
            PG8_WAIT_L(8); PG8_BAR; PG8_WAIT_L(0); PG8_MMA(0, 0, At, B0); PG8_BAR; PG8_SCHED;
            PG8_LDB(B1, 0, 1); PG8_STAGE_B(PG8_SB(0, 0), b2, ldb2);
            PG8_BAR; PG8_WAIT_L(0); PG8_MMA(0, 1, At, B1); PG8_BAR;
            PG8_LDA(At, 0, 1); PG8_STAGE_A(PG8_SA(0, 0), a2, lda2);
            PG8_BAR; PG8_WAIT_L(0); PG8_MMA(1, 0, At, B0); PG8_BAR; PG8_SCHED;
            PG8_STAGE_B(PG8_SB(0, 1), b2 + (size_t)HALF * ldb2, ldb2);
            PG8_WAIT_V(6); PG8_BAR; PG8_MMA(1, 1, At, B1); PG8_BAR;
            PG8_LDB(B0, 1, 0); PG8_SCHED; PG8_LDA(At, 1, 0); PG8_STAGE_A(PG8_SA(0, 1), a2 + (size_t)HALF * lda2, lda2);
            PG8_WAIT_L(8); PG8_BAR; PG8_WAIT_L(0); PG8_MMA(0, 0, At, B0); PG8_BAR; PG8_SCHED;
            PG8_LDB(B1, 1, 1); PG8_STAGE_B(PG8_SB(1, 0), b3, ldb2);
            PG8_BAR; PG8_WAIT_L(0); PG8_MMA(0, 1, At, B1); PG8_BAR;
            PG8_LDA(At, 1, 1); PG8_STAGE_A(PG8_SA(1, 0), a3, lda2);
            PG8_BAR; PG8_WAIT_L(0); PG8_MMA(1, 0, At, B0); PG8_BAR; PG8_SCHED;
            PG8_STAGE_B(PG8_SB(1, 1), b3 + (size_t)HALF * ldb2, ldb2);
            PG8_WAIT_V(6); PG8_BAR; PG8_MMA(1, 1, At, B1); PG8_BAR;
        }
        { int fr2 = fr, fq2 = fq, wr2 = wr, wc2 = wc; asm volatile("" : "+v"(fr2), "+v"(fq2), "+s"(wr2), "+s"(wc2)); E(acc, cur, wr2, wc2, fr2, fq2); }
        if (!has_next) break;
#pragma unroll
        for (int a = 0; a < 2; ++a)
#pragma unroll
            for (int b = 0; b < 2; ++b)
#pragma unroll
                for (int m = 0; m < 4; ++m)
#pragma unroll
                    for (int n = 0; n < 2; ++n) acc[a][b][m][n] = (f32x4){0.f, 0.f, 0.f, 0.f};
        cur = nxt; cA = nA; cB = nB; clda = nlda; cldb = nldb; ++ui;
    }
    PG8_WAIT_V(0);
    if (wr == 0) PG8_BAR;
    PG8_BAR;
#undef PG8_SA
#undef PG8_SB
#undef PG8_STAGE_A
#undef PG8_STAGE_B
#undef PG8_LDA
#undef PG8_LDB
#undef PG8_MMA
#undef PG8_WAIT_V
#undef PG8_WAIT_L
#undef PG8_BAR
#undef PG8_SCHED
}
}
using pg8::GUnit;

struct Params { const float* in[NIN]; float* out; unsigned char* ws; };


#define WSP(T, off) ((T*)(P.ws + (off)))
#define WTP(eoff) ((const bf16_t*)(P.ws + OFF_WT) + (eoff))

__device__ __forceinline__ void tr_tile(const float* __restrict__ src, int ld, int k0, int c0, bf16_t* __restrict__ dst, int K, int r0, LAS float* scr, int tid) {
#pragma unroll
    for (int ps = 0; ps < 2; ++ps) {
        const int i = (tid >> 4) + 32 * ps, j4 = (tid & 15) * 4;
        const f32x4 v = *(const f32x4*)(src + (size_t)(k0 + i) * ld + c0 + j4);
        scr[i * 65 + j4 + 0] = v[0]; scr[i * 65 + j4 + 1] = v[1]; scr[i * 65 + j4 + 2] = v[2]; scr[i * 65 + j4 + 3] = v[3];
    }
    __syncthreads();
    { const int j = tid >> 3, i8 = (tid & 7) * 8;
      u32x4 o; o[0] = pk2(scr[(i8 + 0) * 65 + j], scr[(i8 + 1) * 65 + j]); o[1] = pk2(scr[(i8 + 2) * 65 + j], scr[(i8 + 3) * 65 + j]);
      o[2] = pk2(scr[(i8 + 4) * 65 + j], scr[(i8 + 5) * 65 + j]); o[3] = pk2(scr[(i8 + 6) * 65 + j], scr[(i8 + 7) * 65 + j]);
      *(u32x4*)(dst + (size_t)(r0 + j) * K + k0 + i8) = o; }
    __syncthreads();
}
__device__ __forceinline__ void tr_job(const float* src, int ld, int c0, int K, bf16_t* dst, int t, LAS float* scr, int tid) {
    const int nk = K >> 6, kt = t % nk, rt = t / nk;
    tr_tile(src, ld, kt * 64, c0 + rt * 64, dst, K, rt * 64, scr, tid);
}
constexpr int WC_T0 = 16 * 16, WC_T1 = 16 * 28, WC_T2 = 16 * 64, WC_TBR = 4 * 16, WC_TO = 16 * 16, WC_T1M = 16 * 64, WC_T2M = 64 * 16, WC_TPL = 4 * 16, WC_TPG = 16 * 16,
              WC_TGLU = 4 * 4, WC_TRW = 1 * 4, WC_TRG = 2 * 4;
constexpr int WCONV_TASKS = WC_T0 + WC_T1 + WC_T2 + 4 * WC_TBR + WC_TO + WC_T1M + WC_T2M + WC_TPL + WC_TPG + WC_TGLU + 2 * WC_TRW + WC_TRG + 1;
__device__ __forceinline__ void wconv_task(const Params& P, int L, int t, LAS float* scr, int tid) {
    bf16_t* WT = (bf16_t*)(P.ws + OFF_WT);
    const float* w_in = P.in[IW_IN] + (size_t)L * 1024 * DIN;
    if (t < WC_T0) { tr_job(w_in, DIN, 0, 1024, WT + WT_IN, t, scr, tid); return; } t -= WC_T0;
    if (t < WC_T1) { tr_job(w_in, DIN, 1028, 1024, WT + WT_IN + (size_t)1024 * 1024, t, scr, tid); return; } t -= WC_T1;
    if (t < WC_T2) { tr_job(w_in, DIN, 2820, 1024, WT + WT_IN + (size_t)2820 * 1024, t, scr, tid); return; } t -= WC_T2;
    if (t < 4 * WC_TBR) { const int n = t / WC_TBR; tr_job(P.in[IW_BR] + ((size_t)L * 4 + n) * 256 * 1024, 1024, 0, 256, WT + WT_BR + (size_t)n * 1024 * 256, t % WC_TBR, scr, tid); return; } t -= 4 * WC_TBR;
    if (t < WC_TO) { tr_job(P.in[IW_OUT] + (size_t)L * 1024 * 1024, 1024, 0, 1024, WT + WT_OUT, t, scr, tid); return; } t -= WC_TO;
    if (t < WC_T1M) { tr_job(P.in[IW1] + (size_t)L * 1024 * 4096, 4096, 0, 1024, WT + WT_W1, t, scr, tid); return; } t -= WC_T1M;
    if (t < WC_T2M) { tr_job(P.in[IW2] + (size_t)L * 4096 * 1024, 1024, 0, 4096, WT + WT_W2, t, scr, tid); return; } t -= WC_T2M;
    if (t < WC_TPL) { tr_job(P.in[IPLE_W] + (size_t)L * 256 * 1024, 1024, 0, 256, WT + WT_PL, t, scr, tid); return; } t -= WC_TPL;
    if (t < WC_TPG) { tr_job(P.in[IPLE_G] + (size_t)L * 1024 * 1024, 1024, 0, 1024, WT + WT_PG, t, scr, tid); return; } t -= WC_TPG;
    if (t < WC_TGLU) { tr_job(P.in[IS5_GLUW] + (size_t)L * 256 * 256, 256, 0, 256, WT + WT_GLU, t, scr, tid); return; } t -= WC_TGLU;
    if (t < WC_TRW) { tr_job(P.in[IRW_W2] + (size_t)L * 64 * 256, 256, 0, 64, WT + WT_RW2, t, scr, tid); return; } t -= WC_TRW;
    if (t < WC_TRW) { tr_job(P.in[IRW_A2] + (size_t)L * 64 * 256, 256, 0, 64, WT + WT_RA2, t, scr, tid); return; } t -= WC_TRW;
    if (t < WC_TRG) { tr_job(P.in[IRW_G2] + (size_t)L * 128 * 256, 256, 0, 128, WT + WT_RG2, t, scr, tid); return; } t -= WC_TRG;
    for (int e = tid; e < 4096; e += 512) { const int j = e >> 10, k = e & 1023; WT[WT_IN + (size_t)(2816 + j) * 1024 + k] = (bf16_t)(pk2(w_in[(size_t)k * DIN + 1024 + j], 0.f) & 0xffffu); }
}
__device__ __forceinline__ void cvt_task(const float* __restrict__ src, bf16_t* __restrict__ dst, int t, int tid) {
    const size_t e = (size_t)t * 4096 + tid * 8;
    const f32x4 a = *(const f32x4*)(src + e), b = *(const f32x4*)(src + e + 4);
    u32x4 o; o[0] = pk2(a[0], a[1]); o[1] = pk2(a[2], a[3]); o[2] = pk2(b[0], b[1]); o[3] = pk2(b[2], b[3]);
    *(u32x4*)(dst + e) = o;
}

__device__ __forceinline__ void ln_row(float* zrow, const float* __restrict__ g, const float* __restrict__ b, bf16_t* hbrow, f32x2* stat, bool wr32, int lane) {
    f32x4 v[4]; float s = 0.f;
#pragma unroll
    for (int j = 0; j < 4; ++j) { v[j] = *(const f32x4*)(zrow + 4 * lane + 256 * j); s += (v[j][0] + v[j][1]) + (v[j][2] + v[j][3]); }
    const float mean = wave_sum(s, lane) * (1.f / 1024.f); float s2 = 0.f;
#pragma unroll
    for (int j = 0; j < 4; ++j) { v[j] = v[j] - mean; s2 += (v[j][0] * v[j][0] + v[j][1] * v[j][1]) + (v[j][2] * v[j][2] + v[j][3] * v[j][3]); }
    const float rstd = rsqrtf(wave_sum(s2, lane) * (1.f / 1024.f) + LN_EPS);
    if (stat && lane == 0) { f32x2 st; st[0] = mean; st[1] = rstd; *stat = st; }
#pragma unroll
    for (int j = 0; j < 4; ++j) {
        const f32x4 gg = *(const f32x4*)(g + 4 * lane + 256 * j), bb = *(const f32x4*)(b + 4 * lane + 256 * j);
        const f32x4 o = v[j] * rstd * gg + bb;
        if (wr32) *(f32x4*)(zrow + 4 * lane + 256 * j) = o;
        if (hbrow) { u32x2 q; q[0] = pk2(o[0], o[1]); q[1] = pk2(o[2], o[3]); *(u32x2*)(hbrow + 4 * lane + 256 * j) = q; }
    }
}

#define EPI_LOOP(u) _Pragma("unroll") for (int ai = 0; ai < 2; ++ai) _Pragma("unroll") for (int m = 0; m < 4; ++m) _Pragma("unroll") for (int bj = 0; bj < 2; ++bj)
#define EPI_ROW(u) ((u).pm * 256 + ai * 128 + wr * 64 + m * 16 + fr)
#define EPI_COL(u) ((u).pn * 256 + bj * 128 + wc * 32 + 8 * fq)
#define EPI_E ((ai * 4 + m) * 2 + bj)
#define EPI_ROW2(u) ((u).pm * 256 + ai * 128 + wr * 64 + m * 16 + fr)
#define EPI_GROUPS _Pragma("unroll") for (int ai = 0; ai < 2; ++ai) _Pragma("unroll") for (int mh = 0; mh < 2; ++mh)
#define EPI_IN_GROUP _Pragma("unroll") for (int mm = 0; mm < 2; ++mm) _Pragma("unroll") for (int bj = 0; bj < 2; ++bj)
#define EPI_GI (mm * 2 + bj)
#define EPI_PAIRS _Pragma("unroll") for (int ai = 0; ai < 2; ++ai) _Pragma("unroll") for (int m = 0; m < 4; ++m)
#define EPI_IN_PAIR _Pragma("unroll") for (int bj = 0; bj < 2; ++bj)

struct SchedG1 { const Params& P; int G, c;
    __device__ __forceinline__ bool next(int i, GUnit& u) const {
        const int L = i * G + c; if (L >= 128 * 12) return false;
        pg8::tile_of(L, 128, 12, u.pm, u.pn);
        u.A = (const char*)(P.ws + OFF_HB) + (size_t)u.pm * 256 * 2048; u.lda = 2048;
        u.B = (const char*)(WTP(WT_IN)) + (size_t)u.pn * 256 * 2048; u.ldb = 2048; u.nt = 16; u.kind = 0; return true; } };
struct EpiG1 { const Params& P;
    __device__ __forceinline__ void operator()(const f32x4 (&acc)[2][2][4][2], const GUnit& u, int wr, int wc, int fr, int fq) const {
        bf16_t* PS = WSP(bf16_t, OFF_PS); float* FL = WSP(float, OFF_FL);
        if (u.pn < 11) {
            const float qs = u.pn == 1 ? 0.18033688011112042f : (u.pn == 8 ? 0.18033688011112042f : 1.0f);
            EPI_LOOP(u) { const f32x4 v0 = acc[ai][bj][m][0] * qs, v1 = acc[ai][bj][m][1] * qs; u32x4 o; o[0] = pk2(v0[0], v0[1]); o[1] = pk2(v0[2], v0[3]); o[2] = pk2(v1[0], v1[1]); o[3] = pk2(v1[2], v1[3]);
                *(u32x4*)(PS + (size_t)EPI_ROW(u) * PSLD + EPI_COL(u)) = o; }
        } else if (wc == 0 && fq == 0) {
#pragma unroll
            for (int ai = 0; ai < 2; ++ai)
#pragma unroll
                for (int m = 0; m < 4; ++m) { const int bj = 0; *(f32x4*)(FL + (size_t)EPI_ROW(u) * 4) = acc[ai][0][m][0]; }
        } } };

struct SchedG2 { const Params& P; int G, c;
    __device__ __forceinline__ bool next(int i, GUnit& u) const {
        const int ti = i >> 3, st = i & 7, n = st >> 1; const int L = ti * G + c; if (L >= 128 * 4) return false;
        pg8::tile_of(L, 128, 4, u.pm, u.pn);
        if (!(st & 1)) { u.A = (const char*)(P.ws + OFF_YC) + (size_t)u.pm * 256 * 2048 + n * 512; u.lda = 2048;
            u.B = (const char*)(WTP(WT_BR)) + ((size_t)n * 1024 + u.pn * 256) * 512; u.ldb = 512; u.nt = 4; u.kind = 0; }
        else { u.A = (const char*)(P.ws + OFF_HB) + (size_t)u.pm * 256 * 2048; u.lda = 2048;
            u.B = (const char*)(WTP(WT_IN)) + ((size_t)2820 + n * 1024 + u.pn * 256) * 2048; u.ldb = 2048; u.nt = 16; u.kind = 1 + n; }
        return true; } };
struct EpiG2 { const Params& P;
    __device__ __forceinline__ void operator()(const f32x4 (&acc)[2][2][4][2], const GUnit& u, int wr, int wc, int fr, int fq) const {
        unsigned char* Sb = P.ws + OFF_G2S + (size_t)blockIdx.x * 393216;
        int fr_ = fr; asm volatile("" : "+v"(fr_));
        const unsigned tl16 = (unsigned)((wr * 4 + wc) * 64 + fq * 16 + fr_) * 16u;
#define G2_S(e) (*(u32x4*)(Sb + ({ unsigned o_ = tl16; asm volatile("" : "+v"(o_)); o_ + (e) * 8192u; })))
#define G2_M(e) (*(f32x4*)(Sb + 131072 + ({ unsigned o_ = tl16; asm volatile("" : "+v"(o_)); o_ + (e) * 8192u; })))
        bf16_t* MG = WSP(bf16_t, OFF_MG);
        if (u.kind == 0) {
            EPI_LOOP(u) { const f32x4 v0 = acc[ai][bj][m][0], v1 = acc[ai][bj][m][1]; u32x4 o; o[0] = pk2(v0[0], v0[1]); o[1] = pk2(v0[2], v0[3]); o[2] = pk2(v1[0], v1[1]); o[3] = pk2(v1[2], v1[3]);
                G2_S(EPI_E) = o; }
        } else {
            const int n = u.kind - 1;
#define G2_GATE_T0T1 const f32x4 g0 = acc[ai][bj][m][0], g1 = acc[ai][bj][m][1]; const u32x4 s = sv[EPI_GI]; f32x4 t0, t1; \
                    t0[0] = sigm(g0[0]) * bflo(s[0]); t0[1] = sigm(g0[1]) * bfhi(s[0]); t0[2] = sigm(g0[2]) * bflo(s[1]); t0[3] = sigm(g0[3]) * bfhi(s[1]); \
                    t1[0] = sigm(g1[0]) * bflo(s[2]); t1[1] = sigm(g1[1]) * bfhi(s[2]); t1[2] = sigm(g1[2]) * bflo(s[3]); t1[3] = sigm(g1[3]) * bfhi(s[3]);
#define G2_MB(e) (*(u32x4*)(Sb + 131072 + ({ unsigned o_ = tl16; asm volatile("" : "+v"(o_)); o_ + (e) * 8192u; })))
#define G2_ADDM const u32x4 mq = mv[EPI_GI]; t0[0] += bflo(mq[0]); t0[1] += bfhi(mq[0]); t0[2] += bflo(mq[1]); t0[3] += bfhi(mq[1]); t1[0] += bflo(mq[2]); t1[1] += bfhi(mq[2]); t1[2] += bflo(mq[3]); t1[3] += bfhi(mq[3]);
#define G2_PACK u32x4 o; o[0] = pk2(t0[0], t0[1]); o[1] = pk2(t0[2], t0[3]); o[2] = pk2(t1[0], t1[1]); o[3] = pk2(t1[2], t1[3]);
            if (n == 0) {
                EPI_GROUPS { u32x4 sv[4];
                    EPI_IN_GROUP { const int m = 2 * mh + mm; sv[EPI_GI] = G2_S(EPI_E); }
                    EPI_IN_GROUP { const int m = 2 * mh + mm; G2_GATE_T0T1 G2_PACK G2_MB(EPI_E) = o; }
                    __builtin_amdgcn_sched_barrier(0); }
            } else if (n < 3) {
                EPI_PAIRS { u32x4 sv[2], mv[2];
                    EPI_IN_PAIR { sv[bj] = G2_S(EPI_E); mv[bj] = G2_MB(EPI_E); }
                    EPI_IN_PAIR { const int mm = 0; G2_GATE_T0T1 G2_ADDM G2_PACK G2_MB(EPI_E) = o; }
                    __builtin_amdgcn_sched_barrier(0); }
            } else {
                EPI_PAIRS { u32x4 sv[2], mv[2];
                    EPI_IN_PAIR { sv[bj] = G2_S(EPI_E); mv[bj] = G2_MB(EPI_E); }
                    EPI_IN_PAIR { const int mm = 0; G2_GATE_T0T1 G2_ADDM G2_PACK *(u32x4*)(MG + (size_t)EPI_ROW(u) * 1024 + EPI_COL(u)) = o; }
                    __builtin_amdgcn_sched_barrier(0); }
            }
        } } };

struct SchedG3 { const Params& P; int G, c;
    __device__ __forceinline__ bool next(int i, GUnit& u) const {
        const int L = i * G + c; if (L >= 128 * 4) return false;
        pg8::tile_of(L, 128, 4, u.pm, u.pn);
        u.A = (const char*)(P.ws + OFF_MG) + (size_t)u.pm * 256 * 2048; u.lda = 2048;
        u.B = (const char*)(WTP(WT_OUT)) + (size_t)u.pn * 256 * 2048; u.ldb = 2048; u.nt = 16; u.kind = 0; return true; } };
#define LN_APPLY(zv, st, gv, bv) (((zv) - (st)[0]) * (st)[1] * (gv) + (bv))
struct EpiG3 { const Params& P; const float* hsrc; const float* lng; const float* lnb;
    __device__ __forceinline__ void operator()(const f32x4 (&acc)[2][2][4][2], const GUnit& u, int wr, int wc, int fr, int fq) const {
        if (lng == nullptr) {
            EPI_GROUPS {
                f32x4 ha[4], hb4[4];
                EPI_IN_GROUP { const int m = 2 * mh + mm; const size_t o = (size_t)EPI_ROW(u) * 1024 + EPI_COL(u); ha[EPI_GI] = *(const f32x4*)(hsrc + o); hb4[EPI_GI] = *(const f32x4*)(hsrc + o + 4); }
                EPI_IN_GROUP { const int m = 2 * mh + mm; const size_t o = (size_t)EPI_ROW(u) * 1024 + EPI_COL(u);
                    *(f32x4*)(P.out + o) = ha[EPI_GI] * ALPHA + acc[ai][bj][m][0]; *(f32x4*)(P.out + o + 4) = hb4[EPI_GI] * ALPHA + acc[ai][bj][m][1]; }
                __builtin_amdgcn_sched_barrier(0); }
        } else {
            const f32x2* STAT = WSP(f32x2, OFF_STAT);
            EPI_PAIRS {
                const int row = EPI_ROW2(u); const f32x2 st = STAT[row];
                f32x4 ha[2], hb4[2], g0[2], g1[2], b0[2], b1[2];
                EPI_IN_PAIR { const int col = EPI_COL(u); const size_t o = (size_t)row * 1024 + col; ha[bj] = *(const f32x4*)(hsrc + o); hb4[bj] = *(const f32x4*)(hsrc + o + 4);
                    g0[bj] = *(const f32x4*)(lng + col); g1[bj] = *(const f32x4*)(lng + col + 4); b0[bj] = *(const f32x4*)(lnb + col); b1[bj] = *(const f32x4*)(lnb + col + 4); }
                EPI_IN_PAIR { const size_t o = (size_t)row * 1024 + EPI_COL(u);
                    *(f32x4*)(P.out + o) = LN_APPLY(ha[bj], st, g0[bj], b0[bj]) * ALPHA + acc[ai][bj][m][0]; *(f32x4*)(P.out + o + 4) = LN_APPLY(hb4[bj], st, g1[bj], b1[bj]) * ALPHA + acc[ai][bj][m][1]; }
                __builtin_amdgcn_sched_barrier(0); }
        } } };

struct SchedG4 { const Params& P; int G, c;
    __device__ __forceinline__ bool next(int i, GUnit& u) const {
        const int L = i * G + c; if (L >= 128 * 16) return false;
        pg8::tile_of(L, 128, 16, u.pm, u.pn);
        u.A = (const char*)(P.ws + OFF_HB) + (size_t)u.pm * 256 * 2048; u.lda = 2048;
        u.B = (const char*)(WTP(WT_W1)) + (size_t)u.pn * 256 * 2048; u.ldb = 2048; u.nt = 16; u.kind = 0; return true; } };
struct EpiG4 { const Params& P;
    __device__ __forceinline__ void operator()(const f32x4 (&acc)[2][2][4][2], const GUnit& u, int wr, int wc, int fr, int fq) const {
        bf16_t* U = WSP(bf16_t, OFF_U);
        EPI_LOOP(u) { f32x4 v0 = acc[ai][bj][m][0], v1 = acc[ai][bj][m][1];
#pragma unroll
            for (int j = 0; j < 4; ++j) { const float a = fmaxf(v0[j], 0.f), b = fmaxf(v1[j], 0.f); v0[j] = a * a; v1[j] = b * b; }
            u32x4 o; o[0] = pk2(v0[0], v0[1]); o[1] = pk2(v0[2], v0[3]); o[2] = pk2(v1[0], v1[1]); o[3] = pk2(v1[2], v1[3]);
            *(u32x4*)(U + (size_t)EPI_ROW(u) * 4096 + EPI_COL(u)) = o; } } };

struct SchedG5 { const Params& P; int G, c;
    __device__ __forceinline__ bool next(int i, GUnit& u) const {
        const int ti = i / 3, st = i % 3; const int L = ti * G + c; if (L >= 128 * 4) return false;
        pg8::tile_of(L, 128, 4, u.pm, u.pn); u.kind = st;
        if (st == 0) { u.A = (const char*)(P.ws + OFF_YC) + (size_t)u.pm * 256 * 512; u.lda = 512; u.B = (const char*)(WTP(WT_PL)) + (size_t)u.pn * 256 * 512; u.ldb = 512; u.nt = 4; }
        else if (st == 1) { u.A = (const char*)(P.ws + OFF_HB) + (size_t)u.pm * 256 * 2048; u.lda = 2048; u.B = (const char*)(WTP(WT_PG)) + (size_t)u.pn * 256 * 2048; u.ldb = 2048; u.nt = 16; }
        else { u.A = (const char*)(P.ws + OFF_U) + (size_t)u.pm * 256 * 8192; u.lda = 8192; u.B = (const char*)(WTP(WT_W2)) + (size_t)u.pn * 256 * 8192; u.ldb = 8192; u.nt = 64; }
        return true; } };
struct EpiG5 { const Params& P; const float* lng; const float* lnb;
    __device__ __forceinline__ void operator()(const f32x4 (&acc)[2][2][4][2], const GUnit& u, int wr, int wc, int fr, int fq) const {
        unsigned char* Sb = P.ws + OFF_G5S + (size_t)blockIdx.x * 131072;
        int fr_ = fr; asm volatile("" : "+v"(fr_));
        const unsigned tl16 = (unsigned)((wr * 4 + wc) * 64 + fq * 16 + fr_) * 16u;
        if (u.kind == 0) {
            EPI_LOOP(u) { const f32x4 v0 = acc[ai][bj][m][0], v1 = acc[ai][bj][m][1]; u32x4 o; o[0] = pk2(v0[0], v0[1]); o[1] = pk2(v0[2], v0[3]); o[2] = pk2(v1[0], v1[1]); o[3] = pk2(v1[2], v1[3]);
                G2_S(EPI_E) = o; }
        } else if (u.kind == 1) {
            EPI_GROUPS {
                u32x4 sv[4];
                EPI_IN_GROUP { const int m = 2 * mh + mm; sv[EPI_GI] = G2_S(EPI_E); }
                EPI_IN_GROUP { const int m = 2 * mh + mm; const f32x4 g0 = acc[ai][bj][m][0], g1 = acc[ai][bj][m][1]; const u32x4 s = sv[EPI_GI]; u32x4 o;
                    o[0] = pk2(sigm(g0[0]) * bflo(s[0]), sigm(g0[1]) * bfhi(s[0])); o[1] = pk2(sigm(g0[2]) * bflo(s[1]), sigm(g0[3]) * bfhi(s[1]));
                    o[2] = pk2(sigm(g1[0]) * bflo(s[2]), sigm(g1[1]) * bfhi(s[2])); o[3] = pk2(sigm(g1[2]) * bflo(s[3]), sigm(g1[3]) * bfhi(s[3]));
                    G2_S(EPI_E) = o; }
                __builtin_amdgcn_sched_barrier(0); }
        } else {
            const f32x2* STAT = WSP(f32x2, OFF_STAT);
            EPI_PAIRS {
                const int row = EPI_ROW2(u); const f32x2 st = STAT[row];
                u32x4 sv[2]; f32x4 ha[2], hb4[2], g0[2], g1[2], b0[2], b1[2];
                EPI_IN_PAIR { const int col = EPI_COL(u); const size_t o = (size_t)row * 1024 + col; sv[bj] = G2_S(EPI_E); ha[bj] = *(const f32x4*)(P.out + o); hb4[bj] = *(const f32x4*)(P.out + o + 4);
                    g0[bj] = *(const f32x4*)(lng + col); g1[bj] = *(const f32x4*)(lng + col + 4); b0[bj] = *(const f32x4*)(lnb + col); b1[bj] = *(const f32x4*)(lnb + col + 4); }
                EPI_IN_PAIR { const size_t o = (size_t)row * 1024 + EPI_COL(u); const u32x4 s = sv[bj];
                    f32x4 p0, p1; p0[0] = bflo(s[0]); p0[1] = bfhi(s[0]); p0[2] = bflo(s[1]); p0[3] = bfhi(s[1]); p1[0] = bflo(s[2]); p1[1] = bfhi(s[2]); p1[2] = bflo(s[3]); p1[3] = bfhi(s[3]);
                    *(f32x4*)(P.out + o) = LN_APPLY(ha[bj], st, g0[bj], b0[bj]) * ALPHA + acc[ai][bj][m][0] + p0; *(f32x4*)(P.out + o + 4) = LN_APPLY(hb4[bj], st, g1[bj], b1[bj]) * ALPHA + acc[ai][bj][m][1] + p1; }
                __builtin_amdgcn_sched_barrier(0); }
        } } };

struct S5Lane { float lbr, lbi; float bbr[16], bbi[16]; };
__device__ __forceinline__ void s5_setup(const Params& P, int L, int g, int p, S5Lane& s) {
    const float dt = expf(P.in[IS5_LDT][L * 16 + g]);
    const float lr = P.in[IS5_LRE][(L * 16 + g) * 64 + p], li = P.in[IS5_LIM][(L * 16 + g) * 64 + p];
    const float mag = expf(lr * dt), ang = li * dt;
    s.lbr = mag * cosf(ang); s.lbi = mag * sinf(ang);
    const float den = lr * lr + li * li, nr = s.lbr - 1.0f;
    const float fre = (nr * lr + s.lbi * li) / den, fim = (s.lbi * lr - nr * li) / den;
    const float* br = P.in[IS5_BRE] + ((size_t)(L * 16 + g) * 64 + p) * 16; const float* bi = P.in[IS5_BIM] + ((size_t)(L * 16 + g) * 64 + p) * 16;
#pragma unroll
    for (int q = 0; q < 4; ++q) { const f32x4 a = *(const f32x4*)(br + 4 * q), b = *(const f32x4*)(bi + 4 * q);
#pragma unroll
        for (int j = 0; j < 4; ++j) { s.bbr[4 * q + j] = fre * a[j] - fim * b[j]; s.bbi[4 * q + j] = fre * b[j] + fim * a[j]; } }
}
#define S5_STEP(s, wq, xr, xi) do { float bur = 0.f, bui = 0.f; \
    _Pragma("unroll") for (int q = 0; q < 8; ++q) { const float u0 = bflo(wq[q]), u1 = bfhi(wq[q]); \
        bur = fmaf(s.bbr[2 * q], u0, bur); bui = fmaf(s.bbi[2 * q], u0, bui); bur = fmaf(s.bbr[2 * q + 1], u1, bur); bui = fmaf(s.bbi[2 * q + 1], u1, bui); } \
    const float nxr = s.lbr * xr - s.lbi * xi + bur, nxi = s.lbr * xi + s.lbi * xr + bui; xr = nxr; xi = nxi; } while (0)

__device__ __forceinline__ void s5_pass1(const Params& P, int L, int task, int lane) {
    const int g = task & 15, C = (task >> 4) & 15, b = task >> 8;
    S5Lane s; s5_setup(P, L, g, lane, s);
    const bf16_t* PS = WSP(bf16_t, OFF_PS);
    f32x2* L32 = WSP(f32x2, OFF_L32); f32x2* E256 = WSP(f32x2, OFF_E256);
    float xr = 0.f, xi = 0.f;
    const size_t tok0 = (size_t)b * SEQ + C * 256;
    for (int sub = 0; sub < 4; ++sub) {
        const u32x4* src = (const u32x4*)(PS + (tok0 + sub * 64 + lane) * PSLD + g * 16);
        const u32x4 wa = src[0], wb = src[1];
        for (int t = 0; t < 64; ++t) {
            unsigned wq[8];
#pragma unroll
            for (int q = 0; q < 4; ++q) { wq[q] = __builtin_amdgcn_readlane(wa[q], t); wq[4 + q] = __builtin_amdgcn_readlane(wb[q], t); }
            S5_STEP(s, wq, xr, xi);
            if ((t & 31) == 31) { f32x2 o; o[0] = xr; o[1] = xi; L32[(((size_t)b * 128 + C * 8 + sub * 2 + (t >> 5)) * 16 + g) * 64 + lane] = o; }
        }
    }
    { f32x2 o; o[0] = xr; o[1] = xi; E256[(((size_t)b * 16 + C) * 16 + g) * 64 + lane] = o; }
}
__device__ __forceinline__ void cmul(float& ar, float& ai, float br, float bi) { const float r = ar * br - ai * bi, i = ar * bi + ai * br; ar = r; ai = i; }
__device__ __forceinline__ float gelu_tanh(float x) { return 0.5f * x * (1.f + tanhf(0.7978845608028654f * (x + 0.044715f * x * x * x))); }

__device__ __forceinline__ void s5_pass3(const Params& P, int L, int task, LAS unsigned char* lds, int tid) {
    const int lane = tid & 63, w = tid >> 6, b = task >> 5, c128 = task & 31, C = c128 >> 1, j0 = (c128 & 1) * 4;
    LAS bf16_t* Xs = (LAS bf16_t*)lds + w * (32 * 136); LAS bf16_t* Yg = (LAS bf16_t*)(lds + 69632);
    const bf16_t* PS = WSP(bf16_t, OFF_PS); const f32x2* L32 = WSP(f32x2, OFF_L32); const f32x2* E256 = WSP(f32x2, OFF_E256);
    const int h = lane & 15, quad = lane >> 4;
    const size_t tokb = (size_t)b * SEQ + c128 * 128;
    for (int gi = 0; gi < 2; ++gi) {
        const int g = 2 * w + gi;
        S5Lane s; s5_setup(P, L, g, lane, s);
        float xr = 0.f, xi = 0.f;
        { float pr = s.lbr, pi = s.lbi;
#pragma unroll
          for (int q = 0; q < 5; ++q) cmul(pr, pi, pr, pi);
          float p4r = pr, p4i = pi; cmul(p4r, p4i, p4r, p4i); cmul(p4r, p4i, p4r, p4i);
          float qr = p4r, qi = p4i; cmul(qr, qi, qr, qi);
          f32x2 ev[15];
#pragma unroll
          for (int cc = 0; cc < 15; ++cc) { ev[cc] = (f32x2){0.f, 0.f}; if (cc < C) ev[cc] = E256[(((size_t)b * 16 + cc) * 16 + g) * 64 + lane]; }
          f32x2 el = (f32x2){0.f, 0.f}; if (j0) el = L32[(((size_t)b * 128 + C * 8 + 3) * 16 + g) * 64 + lane];
#pragma unroll
          for (int cc = 0; cc < 15; ++cc) if (cc < C) { cmul(xr, xi, qr, qi); xr += ev[cc][0]; xi += ev[cc][1]; }
          if (j0) { cmul(xr, xi, p4r, p4i); xr += el[0]; xi += el[1]; } }
        bf16x8 bfr[4];
#pragma unroll
        for (int ks = 0; ks < 4; ++ks) {
            const float* cp = (ks < 2 ? P.in[IS5_CRE] : P.in[IS5_CIM]) + ((size_t)(L * 16 + g) * 16 + h) * 64 + (ks & 1) * 32 + quad * 8;
            const f32x4 c0 = *(const f32x4*)cp, c1 = *(const f32x4*)(cp + 4); const float sg = ks < 2 ? 1.f : -1.f;
            u32x4 o; o[0] = pk2(sg * c0[0], sg * c0[1]); o[1] = pk2(sg * c0[2], sg * c0[3]); o[2] = pk2(sg * c1[0], sg * c1[1]); o[3] = pk2(sg * c1[2], sg * c1[3]);
            bfr[ks] = __builtin_bit_cast(bf16x8, o);
        }
        const float dd = P.in[IS5_D][(L * 16 + g) * 16 + h];
        for (int sub = 0; sub < 4; ++sub) {
            const size_t tok0 = tokb + sub * 32;
            const u32x4* src = (const u32x4*)(PS + (tok0 + (lane & 31)) * PSLD + g * 16);
            const u32x4 wa = src[0], wb = src[1];
            LAS bf16_t* Uw = (LAS bf16_t*)(lds + 137216) + w * 512;
            *(LAS u32x4*)(Uw + (lane & 31) * 16) = wa; *(LAS u32x4*)(Uw + (lane & 31) * 16 + 8) = wb;
            for (int t = 0; t < 32; ++t) {
                unsigned wq[8];
#pragma unroll
                for (int q = 0; q < 4; ++q) { wq[q] = __builtin_amdgcn_readlane(wa[q], t); wq[4 + q] = __builtin_amdgcn_readlane(wb[q], t); }
                S5_STEP(s, wq, xr, xi);
                const unsigned pk = pk2(xr, xi);
                Xs[t * 136 + lane] = (bf16_t)(pk & 0xffffu); Xs[t * 136 + 64 + lane] = (bf16_t)(pk >> 16);
            }
#pragma unroll
            for (int tb = 0; tb < 2; ++tb) {
                f32x4 acc = {0.f, 0.f, 0.f, 0.f};
#pragma unroll
                for (int ks = 0; ks < 4; ++ks) { const bf16x8 a = *(const LAS bf16x8*)(Xs + (tb * 16 + h) * 136 + ks * 32 + quad * 8); acc = __builtin_amdgcn_mfma_f32_16x16x32_bf16(a, bfr[ks], acc, 0, 0, 0); }
#pragma unroll
                for (int r = 0; r < 4; ++r) { const int t = tb * 16 + quad * 4 + r;
                    const float uu = bf1(Uw[t * 16 + h]);
                    Yg[(sub * 32 + t) * 264 + g * 16 + h] = (bf16_t)(pk2(gelu_tanh(acc[r] + dd * uu), 0.f) & 0xffffu); }
            }
        }
    }
    __syncthreads();
    {
        bf16_t* YC = WSP(bf16_t, OFF_YC);
#pragma unroll 1
        for (int sub = 0; sub < 4; ++sub) {
            const LAS bf16_t* Ys = Yg + sub * 32 * 264;
            LAS bf16_t* So = (LAS bf16_t*)lds + (sub & 1) * (32 * 264);
            int hl = h; asm volatile("" : "+v"(hl));
#pragma unroll
            for (int nb = 0; nb < 2; ++nb) {
                const int n = 32 * w + 16 * nb + hl; const bf16_t* wrow = WTP(WT_GLU) + (size_t)n * 256 + quad * 8; const float gb = P.in[IS5_GLUB][L * 256 + n];
                f32x4 acc[2] = {{0.f, 0.f, 0.f, 0.f}, {0.f, 0.f, 0.f, 0.f}};
#pragma unroll
                for (int ks = 0; ks < 8; ++ks) { const bf16x8 bb = *(const bf16x8*)(wrow + ks * 32);
#pragma unroll
                    for (int tb = 0; tb < 2; ++tb) { const bf16x8 a = *(const LAS bf16x8*)(Ys + (tb * 16 + h) * 264 + ks * 32 + quad * 8); acc[tb] = __builtin_amdgcn_mfma_f32_16x16x32_bf16(a, bb, acc[tb], 0, 0, 0); } }
#pragma unroll
                for (int tb = 0; tb < 2; ++tb)
#pragma unroll
                    for (int r = 0; r < 4; ++r) { const int t = tb * 16 + quad * 4 + r; const float y = bf1(Ys[t * 264 + n]);
                        So[t * 264 + n] = (bf16_t)(pk2(y * sigm(acc[tb][r] + gb), 0.f) & 0xffffu); }
            }
            __syncthreads();
#pragma unroll
            for (int i = 0; i < 2; ++i) { int tl2 = tid; asm volatile("" : "+v"(tl2)); const int e = tl2 + 512 * i, t = e >> 5, c8 = (e & 31) * 8;
                *(u32x4*)(YC + (tokb + sub * 32 + t) * 1024 + c8) = *(const LAS u32x4*)(So + t * 264 + c8); }
        }
    }
    __syncthreads();
}

__device__ __forceinline__ void cl_task(const Params& P, int L, int task, int lane) {
    const int b = task >> 6, tl = task & 63; const float* FL = WSP(float, OFF_FL); float* CL = WSP(float, OFF_CL);
    const f32x4 f = *(const f32x4*)(FL + ((size_t)b * SEQ + tl * 64 + lane) * 4);
#pragma unroll
    for (int h = 0; h < 4; ++h) {
        const float x = f[h] + P.in[IFOX_B][L * 4 + h];
        float v = fminf(x, 0.f) - log1pf(expf(-fabsf(x)));
#pragma unroll
        for (int o = 1; o < 64; o <<= 1) { const float n = lane_get(v, (lane - o) & 63); if (lane >= o) v += n; }
        CL[((size_t)b * 4 + h) * SEQ + tl * 64 + lane] = v;
    }
}

__device__ __forceinline__ void rwkv_prep(const Params& P, int L, int task, LAS unsigned char* lds, int tid) {
    const int lane = tid & 63, w = tid >> 6; const size_t tok0 = (size_t)task * 32;
    LAS bf16_t* At = (LAS bf16_t*)lds; LAS bf16_t* Aa = (LAS bf16_t*)(lds + 4608); LAS bf16_t* Ag = (LAS bf16_t*)(lds + 9216);
    LAS float* Lw = (LAS float*)(lds + 17920); LAS float* La = (LAS float*)(lds + 51200); LAS float* Lg = (LAS float*)(lds + 84480);
    const bf16_t* PS = WSP(bf16_t, OFF_PS); const float* mu = P.in[IRW_MU] + (size_t)L * 1024;
#pragma unroll
    for (int i = 0; i < 2; ++i) {
        const int e = tid + 512 * i, tl = e >> 5, cg = e & 31, c = cg * 8; const size_t tok = tok0 + tl; const int rc = 768 + c;
        const u32x4 cu = *(const u32x4*)(PS + tok * PSLD + 1024 + rc);
        const bool first = (tok % SEQ) == 0;
        const u32x4 pv = *(const u32x4*)(PS + (tok - (first ? 0 : 1)) * PSLD + 1024 + rc);
        const f32x4 m0 = *(const f32x4*)(mu + rc), m1 = *(const f32x4*)(mu + rc + 4);
        float xs[8];
#pragma unroll
        for (int j = 0; j < 4; ++j) { const float c0 = bflo(cu[j]), c1 = bfhi(cu[j]); const float p0 = first ? 0.f : bflo(pv[j]), p1 = first ? 0.f : bfhi(pv[j]);
            const float ma = j < 2 ? m0[2 * j] : m1[2 * j - 4], mb = j < 2 ? m0[2 * j + 1] : m1[2 * j - 3];
            xs[2 * j] = c0 + (p0 - c0) * ma; xs[2 * j + 1] = c1 + (p1 - c1) * mb; }
        u32x4 o;
        if (c < 64) {
#pragma unroll
            for (int j = 0; j < 4; ++j) o[j] = pk2(1.f - 2.f * __builtin_amdgcn_rcpf(1.f + __expf(2.f * xs[2 * j])), 1.f - 2.f * __builtin_amdgcn_rcpf(1.f + __expf(2.f * xs[2 * j + 1])));
            *(LAS u32x4*)(At + tl * 72 + c) = o;
        } else if (c < 128) {
#pragma unroll
            for (int j = 0; j < 4; ++j) o[j] = pk2(xs[2 * j], xs[2 * j + 1]);
            *(LAS u32x4*)(Aa + tl * 72 + c - 64) = o;
        } else {
#pragma unroll
            for (int j = 0; j < 4; ++j) o[j] = pk2(sigm(xs[2 * j]), sigm(xs[2 * j + 1]));
            *(LAS u32x4*)(Ag + tl * 136 + c - 128) = o;
        }
    }
    __syncthreads();
    {
        const int h = lane & 15, quad = lane >> 4;
#pragma unroll
        for (int nb = 0; nb < 2; ++nb) {
            const int n = 32 * w + 16 * nb + h;
            f32x4 aw[2] = {{0.f, 0.f, 0.f, 0.f}, {0.f, 0.f, 0.f, 0.f}}, aa[2] = {{0.f, 0.f, 0.f, 0.f}, {0.f, 0.f, 0.f, 0.f}}, ag[2] = {{0.f, 0.f, 0.f, 0.f}, {0.f, 0.f, 0.f, 0.f}};
#pragma unroll
            for (int ks = 0; ks < 2; ++ks) {
                const bf16x8 bw = *(const bf16x8*)(WTP(WT_RW2) + (size_t)n * 64 + ks * 32 + quad * 8), ba = *(const bf16x8*)(WTP(WT_RA2) + (size_t)n * 64 + ks * 32 + quad * 8);
#pragma unroll
                for (int tb = 0; tb < 2; ++tb) {
                    aw[tb] = __builtin_amdgcn_mfma_f32_16x16x32_bf16(*(const LAS bf16x8*)(At + (tb * 16 + h) * 72 + ks * 32 + quad * 8), bw, aw[tb], 0, 0, 0);
                    aa[tb] = __builtin_amdgcn_mfma_f32_16x16x32_bf16(*(const LAS bf16x8*)(Aa + (tb * 16 + h) * 72 + ks * 32 + quad * 8), ba, aa[tb], 0, 0, 0); }
            }
#pragma unroll
            for (int ks = 0; ks < 4; ++ks) {
                const bf16x8 bg = *(const bf16x8*)(WTP(WT_RG2) + (size_t)n * 128 + ks * 32 + quad * 8);
#pragma unroll
                for (int tb = 0; tb < 2; ++tb) ag[tb] = __builtin_amdgcn_mfma_f32_16x16x32_bf16(*(const LAS bf16x8*)(Ag + (tb * 16 + h) * 136 + ks * 32 + quad * 8), bg, ag[tb], 0, 0, 0);
            }
#pragma unroll
            for (int tb = 0; tb < 2; ++tb)
#pragma unroll
                for (int r = 0; r < 4; ++r) { const int t = tb * 16 + quad * 4 + r; Lw[t * 260 + n] = aw[tb][r]; La[t * 260 + n] = aa[tb][r]; Lg[t * 260 + n] = ag[tb][r];
                }
        }
    }
    __syncthreads();
    {
        const int tl = tid >> 4, q16 = tid & 15; const size_t tok = tok0 + tl; const bool first = (tok % SEQ) == 0;
        const bf16_t* cur = PS + tok * PSLD + 1024; const bf16_t* prv = PS + (tok - (first ? 0 : 1)) * PSLD + 1024;
        float* DEC = WSP(float, OFF_RW_DEC); bf16_t* RR = WSP(bf16_t, OFF_RW_R); bf16_t* RK = WSP(bf16_t, OFF_RW_K); bf16_t* RV = WSP(bf16_t, OFF_RW_V);
        bf16_t* RKK = WSP(bf16_t, OFF_RW_KK); bf16_t* RB = WSP(bf16_t, OFF_RW_B); bf16_t* RG = WSP(bf16_t, OFF_RW_G);
#define UNPK8(dst, q) do { dst[0] = bflo(q[0]); dst[1] = bfhi(q[0]); dst[2] = bflo(q[1]); dst[3] = bfhi(q[1]); dst[4] = bflo(q[2]); dst[5] = bfhi(q[2]); dst[6] = bflo(q[3]); dst[7] = bfhi(q[3]); } while (0)
#define SHIFT8(xo, off) do { const u32x4 a_ = *(const u32x4*)(cur + (off) + c), b_ = *(const u32x4*)(prv + (off) + c); const f32x4 m0_ = *(const f32x4*)(mu + (off) + c), m1_ = *(const f32x4*)(mu + (off) + c + 4); \
            float cu_[8], pv_[8]; UNPK8(cu_, a_); UNPK8(pv_, b_); _Pragma("unroll") for (int j = 0; j < 8; ++j) xo[j] = cu_[j] + ((first ? 0.f : pv_[j]) - cu_[j]) * (j < 4 ? m0_[j & 3] : m1_[j & 3]); } while (0)
#define PK8(v) ({ u32x4 o_; o_[0] = pk2(v[0], v[1]); o_[1] = pk2(v[2], v[3]); o_[2] = pk2(v[4], v[5]); o_[3] = pk2(v[6], v[7]); o_; })
#pragma unroll
        for (int ps = 0; ps < 2; ++ps) {
            const int hh = 2 * ps + (q16 >> 3), c = hh * 64 + (q16 & 7) * 8;
            float xr[8], xk[8], xv[8];
            SHIFT8(xr, 0); SHIFT8(xk, 256); SHIFT8(xv, 512);
            float w0[8], a0[8], kkw[8], kaw[8], lw[8], la[8], lg[8];
#define LD8G(dst, p) do { const f32x4 a_ = *(const f32x4*)(p), b_ = *(const f32x4*)((p) + 4); _Pragma("unroll") for (int j = 0; j < 4; ++j) { dst[j] = a_[j]; dst[4 + j] = b_[j]; } } while (0)
#define LD8L(dst, p) do { const f32x4 a_ = *(const LAS f32x4*)(p), b_ = *(const LAS f32x4*)((p) + 4); _Pragma("unroll") for (int j = 0; j < 4; ++j) { dst[j] = a_[j]; dst[4 + j] = b_[j]; } } while (0)
            LD8G(w0, P.in[IRW_W0] + L * 256 + c); LD8G(a0, P.in[IRW_A0] + L * 256 + c); LD8G(kkw, P.in[IRW_KK] + L * 256 + c); LD8G(kaw, P.in[IRW_KA] + L * 256 + c);
            LD8L(lw, Lw + tl * 260 + c); LD8L(la, La + tl * 260 + c); LD8L(lg, Lg + tl * 260 + c);
            float dec[8], av[8], kx[8], kn[8]; float ss = 0.f;
#pragma unroll
            for (int j = 0; j < 8; ++j) {
                const float wl = w0[j] + lw[j];
                const float wv = -(fmaxf(-wl, 0.f) + __logf(1.f + __expf(-fabsf(wl)))) - 0.5f;
                dec[j] = __expf(-__expf(wv));
                av[j] = sigm(a0[j] + la[j]);
                kx[j] = xk[j] * kkw[j]; ss += kx[j] * kx[j];
                kn[j] = xk[j] * (1.f + (av[j] - 1.f) * kaw[j]);
            }
            ss += __builtin_bit_cast(float, __builtin_amdgcn_update_dpp(0, __builtin_bit_cast(int, ss), 0xB1, 0xf, 0xf, false));
            ss += __builtin_bit_cast(float, __builtin_amdgcn_update_dpp(0, __builtin_bit_cast(int, ss), 0x4E, 0xf, 0xf, false));
            ss += __builtin_bit_cast(float, __builtin_amdgcn_update_dpp(0, __builtin_bit_cast(int, ss), 0x141, 0xf, 0xf, false));
            const float inv = __builtin_amdgcn_rcpf(fmaxf(__builtin_amdgcn_sqrtf(ss), 1e-12f));
            float kkn[8], bv[8];
#pragma unroll
            for (int j = 0; j < 8; ++j) { kkn[j] = kx[j] * inv; bv[j] = kkn[j] * av[j]; }
            const size_t o = tok * 256 + c;
            { f32x4 d4; d4[0] = dec[0]; d4[1] = dec[1]; d4[2] = dec[2]; d4[3] = dec[3]; *(f32x4*)(DEC + o) = d4; d4[0] = dec[4]; d4[1] = dec[5]; d4[2] = dec[6]; d4[3] = dec[7]; *(f32x4*)(DEC + o + 4) = d4; }
            *(u32x4*)(RR + o) = PK8(xr); *(u32x4*)(RK + o) = PK8(kn); *(u32x4*)(RV + o) = PK8(xv); *(u32x4*)(RKK + o) = PK8(kkn); *(u32x4*)(RB + o) = PK8(bv); *(u32x4*)(RG + o) = PK8(lg);
        }
#undef UNPK8
#undef SHIFT8
#undef PK8
#undef LD8G
#undef LD8L
    }
    __syncthreads();
}

constexpr int RS_BUF = 43008, RS_Y = 2 * RS_BUF;
struct RwLoad { u32x2 r, k, kk, b; f32x4 d; bf16_t v; };
__device__ __forceinline__ void rw_load(const Params& P, int b, int h, int qtr, int chunk, int tid, RwLoad& x) {
    const int t = tid >> 4, c4 = (tid & 15) * 4; const size_t tok = (size_t)b * SEQ + chunk * 32 + t; const size_t o = tok * 256 + h * 64 + c4;
    x.r = *(const u32x2*)(WSP(bf16_t, OFF_RW_R) + o); x.k = *(const u32x2*)(WSP(bf16_t, OFF_RW_K) + o); x.kk = *(const u32x2*)(WSP(bf16_t, OFF_RW_KK) + o);
    x.b = *(const u32x2*)(WSP(bf16_t, OFF_RW_B) + o); x.d = *(const f32x4*)(WSP(float, OFF_RW_DEC) + o);
    x.v = WSP(bf16_t, OFF_RW_V)[tok * 256 + h * 64 + qtr * 16 + (tid & 15)];
}
__device__ __forceinline__ void rw_store(LAS unsigned char* buf, int tid, const RwLoad& x) {
    const int t = tid >> 4, c4 = (tid & 15) * 4;
    f32x4 v; v[0] = bflo(x.r[0]); v[1] = bfhi(x.r[0]); v[2] = bflo(x.r[1]); v[3] = bfhi(x.r[1]); *(LAS f32x4*)(buf + (t * 64 + c4) * 4) = v;
    *(LAS f32x4*)(buf + 8192 + (t * 64 + c4) * 4) = x.d;
    v[0] = bflo(x.k[0]); v[1] = bfhi(x.k[0]); v[2] = bflo(x.k[1]); v[3] = bfhi(x.k[1]); *(LAS f32x4*)(buf + 16384 + (t * 64 + c4) * 4) = v;
    v[0] = bflo(x.kk[0]); v[1] = bfhi(x.kk[0]); v[2] = bflo(x.kk[1]); v[3] = bfhi(x.kk[1]); *(LAS f32x4*)(buf + 24576 + (t * 64 + c4) * 4) = v;
    v[0] = bflo(x.b[0]); v[1] = bfhi(x.b[0]); v[2] = bflo(x.b[1]); v[3] = bfhi(x.b[1]); *(LAS f32x4*)(buf + 32768 + (t * 64 + c4) * 4) = v;
    *(LAS float*)(buf + 40960 + (t * 16 + (tid & 15)) * 4) = bf1(x.v);
}
struct RwStep { f32x4 kk4, w4, k4, b4, r4; float vv; };
__device__ __forceinline__ void rw_read(const LAS unsigned char* buf, int t, int kq, int row, RwStep& s) {
    s.kk4 = *(const LAS f32x4*)(buf + 24576 + (t * 64 + kq * 4) * 4); s.w4 = *(const LAS f32x4*)(buf + 8192 + (t * 64 + kq * 4) * 4);
    s.k4 = *(const LAS f32x4*)(buf + 16384 + (t * 64 + kq * 4) * 4); s.b4 = *(const LAS f32x4*)(buf + 32768 + (t * 64 + kq * 4) * 4);
    s.r4 = *(const LAS f32x4*)(buf + (t * 64 + kq * 4) * 4); s.vv = *(const LAS float*)(buf + 40960 + (t * 16 + row) * 4);
}
struct RwLoad8 { u32x4 r, k, kk, b; f32x4 d0, d1; unsigned v; };
__device__ __forceinline__ void rw_load8(const Params& P, int b, int h, int qtr, int chunk, int lt, RwLoad8& x) {
    const int t = lt >> 3, c8 = (lt & 7) * 8; const size_t tok = (size_t)b * SEQ + chunk * 32 + t; const size_t o = tok * 256 + h * 64 + c8;
    x.r = *(const u32x4*)(WSP(bf16_t, OFF_RW_R) + o); x.k = *(const u32x4*)(WSP(bf16_t, OFF_RW_K) + o); x.kk = *(const u32x4*)(WSP(bf16_t, OFF_RW_KK) + o);
    x.b = *(const u32x4*)(WSP(bf16_t, OFF_RW_B) + o); x.d0 = *(const f32x4*)(WSP(float, OFF_RW_DEC) + o); x.d1 = *(const f32x4*)(WSP(float, OFF_RW_DEC) + o + 4);
    x.v = *(const unsigned*)(WSP(bf16_t, OFF_RW_V) + tok * 256 + h * 64 + qtr * 16 + (lt & 7) * 2);
}
__device__ __forceinline__ void rw_put8(LAS unsigned char* p, const u32x4& q) {
    f32x4 v; v[0] = bflo(q[0]); v[1] = bfhi(q[0]); v[2] = bflo(q[1]); v[3] = bfhi(q[1]); *(LAS f32x4*)p = v;
    v[0] = bflo(q[2]); v[1] = bfhi(q[2]); v[2] = bflo(q[3]); v[3] = bfhi(q[3]); *(LAS f32x4*)(p + 16) = v;
}
__device__ __forceinline__ void rw_store8(LAS unsigned char* buf, int lt, const RwLoad8& x) {
    const int t = lt >> 3, c8 = (lt & 7) * 8; LAS unsigned char* p = buf + (t * 64 + c8) * 4;
    rw_put8(p, x.r); *(LAS f32x4*)(p + 8192) = x.d0; *(LAS f32x4*)(p + 8192 + 16) = x.d1; rw_put8(p + 16384, x.k); rw_put8(p + 24576, x.kk); rw_put8(p + 32768, x.b);
    f32x2 vv; vv[0] = bflo(x.v); vv[1] = bfhi(x.v); *(LAS f32x2*)(buf + 40960 + (t * 16 + (lt & 7) * 2) * 4) = vv;
}
__device__ __forceinline__ void rwkv_scan(const Params& P, int task, LAS unsigned char* lds, int tid) {
    const int lane = tid & 63, w = tid >> 6, qtr = task & 3, h = (task >> 2) & 3, b = task >> 4;
    constexpr int RS_Y2 = 2 * RS_BUF;
    if (w >= 4) {
        const int lt = tid - 256;
        RwLoad8 x;
        rw_load8(P, b, h, qtr, 0, lt, x); rw_store8(lds, lt, x);
        __syncthreads();
        for (int ch = 0; ch < 128; ++ch) {
            if (ch + 1 < 128) rw_load8(P, b, h, qtr, ch + 1, lt, x);
            if (ch > 0) {
                const int t = lt >> 3, r2 = (lt & 7) * 2; const size_t tok = (size_t)b * SEQ + (ch - 1) * 32 + t;
                const f32x2 yy = *(const LAS f32x2*)(lds + RS_Y2 + ((ch - 1) & 1) * 2048 + (t * 16 + r2) * 4);
                *(f32x2*)((char*)(P.ws + OFF_PS + 2048) + tok * (PSLD * 2) + (h * 64 + qtr * 16 + r2) * 4) = yy;
            }
            if (ch + 1 < 128) rw_store8(lds + ((ch + 1) & 1) * RS_BUF, lt, x);
            __syncthreads();
        }
        { const int t = lt >> 3, r2 = (lt & 7) * 2; const size_t tok = (size_t)b * SEQ + 127 * 32 + t;
          const f32x2 yy = *(const LAS f32x2*)(lds + RS_Y2 + (127 & 1) * 2048 + (t * 16 + r2) * 4);
          *(f32x2*)((char*)(P.ws + OFF_PS + 2048) + tok * (PSLD * 2) + (h * 64 + qtr * 16 + r2) * 4) = yy; }
    } else {
        const int kq = lane & 15, row = w * 4 + (lane >> 4);
        f32x2 Sa = {0.f, 0.f}, Sb = {0.f, 0.f};
        __syncthreads();
        for (int ch = 0; ch < 128; ++ch) {
            const LAS unsigned char* buf = lds + (ch & 1) * RS_BUF;
            LAS float* Y = (LAS float*)(lds + RS_Y2 + (ch & 1) * 2048);
            RwStep sa_, sb_, sc_; rw_read(buf, 0, kq, row, sa_); rw_read(buf, 1, kq, row, sb_);
#define LO2(v) ((f32x2){(v)[0], (v)[1]})
#define HI2(v) ((f32x2){(v)[2], (v)[3]})
            float p; { f32x2 tp = Sa * LO2(sa_.kk4); tp = Sb * HI2(sa_.kk4) + tp; p = rowsum16(tp[0] + tp[1]); }
#define RW_STEP(cur, nxt, far, tt) do { \
                rw_read(buf, (tt) + 2 < 32 ? (tt) + 2 : 31, kq, row, far); \
                const f32x2 nsa2 = {-p, -p}, vv2 = {cur.vv, cur.vv}; \
                Sa = Sa * LO2(cur.w4) + (nsa2 * LO2(cur.b4) + vv2 * LO2(cur.k4)); Sb = Sb * HI2(cur.w4) + (nsa2 * HI2(cur.b4) + vv2 * HI2(cur.k4)); \
                f32x2 ty = Sa * LO2(cur.r4), tq = Sa * LO2(nxt.kk4); ty = Sb * HI2(cur.r4) + ty; tq = Sb * HI2(nxt.kk4) + tq; \
                float y = ty[0] + ty[1], q = tq[0] + tq[1]; \
                rowsum16x2(y, q); \
                Y[(tt) * 16 + row] = y; \
                p = q; } while (0)
#pragma unroll 1
            for (int t = 0; t < 30; t += 3) { RW_STEP(sa_, sb_, sc_, t); RW_STEP(sb_, sc_, sa_, t + 1); RW_STEP(sc_, sa_, sb_, t + 2); }
            RW_STEP(sa_, sb_, sc_, 30); RW_STEP(sb_, sc_, sa_, 31);
#undef LO2
#undef HI2
#undef RW_STEP
            __syncthreads();
        }
    }
    __syncthreads();
}

__device__ __forceinline__ void rwkv_post(const Params& P, int L, size_t tok, int lane) {
    const int c = lane * 4, hh = lane >> 4;
    const f32x4 y = *(const f32x4*)((const char*)(P.ws + OFF_PS + 2048) + tok * (PSLD * 2) + c * 4);
    const float mean = rowsum16((y[0] + y[1]) + (y[2] + y[3])) * (1.f / 64.f);
    const f32x4 d = y - mean;
    const float var = rowsum16((d[0] * d[0] + d[1] * d[1]) + (d[2] * d[2] + d[3] * d[3])) * (1.f / 64.f);
    const float rstd = rsqrtf(var + GN_EPS);
    const size_t o = tok * 256 + c;
    const u32x2 r2 = *(const u32x2*)(WSP(bf16_t, OFF_RW_R) + o), k2 = *(const u32x2*)(WSP(bf16_t, OFF_RW_K) + o), v2 = *(const u32x2*)(WSP(bf16_t, OFF_RW_V) + o), g2 = *(const u32x2*)(WSP(bf16_t, OFF_RW_G) + o);
    const float r[4] = {bflo(r2[0]), bfhi(r2[0]), bflo(r2[1]), bfhi(r2[1])}, k[4] = {bflo(k2[0]), bfhi(k2[0]), bflo(k2[1]), bfhi(k2[1])},
                v[4] = {bflo(v2[0]), bfhi(v2[0]), bflo(v2[1]), bfhi(v2[1])}, g[4] = {bflo(g2[0]), bfhi(g2[0]), bflo(g2[1]), bfhi(g2[1])};
    const f32x4 rk = *(const f32x4*)(P.in[IRW_RK] + L * 256 + c), lg = *(const f32x4*)(P.in[IRW_LNG] + L * 256 + c), lb = *(const f32x4*)(P.in[IRW_LNB] + L * 256 + c);
    float bs = 0.f;
#pragma unroll
    for (int j = 0; j < 4; ++j) bs += r[j] * k[j] * rk[j];
    bs = rowsum16(bs);
    float o4[4];
#pragma unroll
    for (int j = 0; j < 4; ++j) o4[j] = (d[j] * rstd * lg[j] + lb[j] + bs * v[j]) * g[j];
    u32x2 t; t[0] = pk2(o4[0], o4[1]); t[1] = pk2(o4[2], o4[3]);
    *(u32x2*)(WSP(bf16_t, OFF_YC) + tok * 1024 + 512 + c) = t;
    (void)hh;
}

#define MFMA32(a, b, c) __builtin_amdgcn_mfma_f32_32x32x16_bf16(a, b, c, 0, 0, 0)
struct TileRegs { u32x4 k, v; float bias; };
template <bool SB>
__device__ __forceinline__ void attn_load(const Params& P, size_t tokb, int h, int j, int tid, float coff, const float* clrow, TileRegs& x) {
    const bf16_t* PS = WSP(bf16_t, OFF_PS); constexpr int KC = SB ? 2304 : 512, VC = SB ? 2560 : 768;
    x.k = *(const u32x4*)(PS + (tokb + 64 * j + (tid >> 3)) * PSLD + KC + h * 64 + (tid & 7) * 8);
    x.v = *(const u32x4*)(PS + (tokb + 64 * j + (tid >> 3)) * PSLD + VC + h * 64 + (tid & 7) * 8);
    if (!SB) x.bias = -(coff + clrow[64 * j + (tid & 63)]) * 1.4426950408889634f;
}
template <bool SB>
__device__ __forceinline__ void attn_store(LAS unsigned char* lds, int buf, int tid, const TileRegs& x) {
    *(LAS u32x4*)(lds + buf * 9216 + ((tid >> 3) * 72 + (tid & 7) * 8) * 2) = x.k;
    *(LAS u32x4*)(lds + 18432 + buf * 9216 + ((tid >> 3) * 72 + (tid & 7) * 8) * 2) = x.v;
    if (!SB) { if (tid < 64) *(LAS float*)(lds + 36864 + buf * 256 + tid * 4) = x.bias; }
}
template <bool SB>
__device__ __forceinline__ void attn_unit(const Params& P, int b, int h, int qb, LAS unsigned char* lds, int tid) {
    const int lane = tid & 63, r32 = lane & 31, hi = lane >> 5, w = tid >> 6;
    const size_t tokb = (size_t)b * SEQ; const int q0 = qb * 256, qw0 = q0 + 32 * w, qpos = qw0 + r32, jd = qw0 >> 6;
    const bf16_t* PS = WSP(bf16_t, OFF_PS); constexpr int QC = SB ? 2048 : 256, OC = SB ? 768 : 256;
    const float* clrow = WSP(float, OFF_CL) + ((size_t)b * 4 + h) * SEQ;
    bf16x8 qr[4];
#pragma unroll
    for (int d0 = 0; d0 < 4; ++d0) qr[d0] = *(const bf16x8*)(PS + (tokb + qpos) * PSLD + QC + h * 64 + d0 * 16 + hi * 8);
    f32x16 O0, O1;
#pragma unroll
    for (int r = 0; r < 16; ++r) { O0[r] = 0.f; O1[r] = 0.f; }
    float mrun = -INFINITY, lrun = 0.f, Rrun = 0.f, coff = 0.f;
    const int NT = 4 * qb + 4;
    TileRegs x;
    { const int j = SB ? NT - 1 : 0; attn_load<SB>(P, tokb, h, j, tid, coff, clrow, x); attn_store<SB>(lds, 0, tid, x); if (!SB) coff += clrow[64 * j + 63]; }
    __syncthreads();
    for (int it = 0; it < NT; ++it) {
        const int j = SB ? NT - 1 - it : it, buf = it & 1; const bool more = it + 1 < NT;
        if (more) { const int jn = SB ? j - 1 : j + 1; attn_load<SB>(P, tokb, h, jn, tid, coff, clrow, x); if (!SB) coff += clrow[64 * jn + 63]; }
        if (j <= jd) {
            const LAS bf16_t* Ks = (const LAS bf16_t*)(lds + buf * 9216); const LAS bf16_t* Vt = (const LAS bf16_t*)(lds + 18432 + buf * 9216);
            f32x16 p0, p1;
            if (!SB) {
                const LAS float* bs0 = (const LAS float*)(lds + 36864 + buf * 256);
#pragma unroll
                for (int rq = 0; rq < 4; ++rq) { const f32x4 b0 = *(const LAS f32x4*)(bs0 + 8 * rq + 4 * hi), b1 = *(const LAS f32x4*)(bs0 + 32 + 8 * rq + 4 * hi);
#pragma unroll
                    for (int i = 0; i < 4; ++i) { p0[4 * rq + i] = b0[i]; p1[4 * rq + i] = b1[i]; } }
            } else {
#pragma unroll
                for (int r = 0; r < 16; ++r) { p0[r] = 0.f; p1[r] = 0.f; }
            }
            __builtin_amdgcn_s_setprio(1);
#pragma unroll
            for (int d0 = 0; d0 < 4; ++d0) {
                const bf16x8 a0 = *(const LAS bf16x8*)(Ks + r32 * 72 + d0 * 16 + hi * 8), a1 = *(const LAS bf16x8*)(Ks + (32 + r32) * 72 + d0 * 16 + hi * 8);
                p0 = MFMA32(a0, qr[d0], p0); p1 = MFMA32(a1, qr[d0], p1);
            }
            __builtin_amdgcn_s_setprio(0);
            const int kbase = 64 * j + 4 * hi;
            bf16x8 pf[4];
            if (!SB) {
                float mt = -INFINITY;
                if (j == jd) {
#pragma unroll
                    for (int rq = 0; rq < 4; ++rq)
#pragma unroll
                        for (int i = 0; i < 4; ++i) { const int r = 4 * rq + i; const int kp = kbase + i + 8 * rq;
                            if (kp > qpos) p0[r] = -INFINITY; if (kp + 32 > qpos) p1[r] = -INFINITY; }
                }
#pragma unroll
                for (int r = 0; r < 16; ++r) mt = fmaxf(mt, fmaxf(p0[r], p1[r]));
                mt = fmaxf(mt, other_half(mt, hi));
                const float mnew = fmaxf(mrun, mt), alpha = __builtin_amdgcn_exp2f(mrun - mnew); mrun = mnew;
                float ls = 0.f;
#pragma unroll
                for (int r = 0; r < 16; ++r) { p0[r] = __builtin_amdgcn_exp2f(p0[r] - mnew); p1[r] = __builtin_amdgcn_exp2f(p1[r] - mnew); ls += p0[r] + p1[r]; }
                lrun = lrun * alpha + ls;
#pragma unroll
                for (int r = 0; r < 16; ++r) { O0[r] *= alpha; O1[r] *= alpha; }
            } else {
                float gs[2][4], og[2][4]; f32x16 lr0, lr1;
#pragma unroll
                for (int rq = 0; rq < 4; ++rq) { float g0 = 0.f, g1 = 0.f;
#pragma unroll
                    for (int i = 0; i < 4; ++i) { const int r = 4 * rq + i; const int kp = kbase + i + 8 * rq;
                        const float z0 = p0[r], z1 = p1[r];
                        const float sp0 = fmaxf(z0, 0.f) + __builtin_amdgcn_logf(1.f + __builtin_amdgcn_exp2f(-fabsf(z0))), sp1 = fmaxf(z1, 0.f) + __builtin_amdgcn_logf(1.f + __builtin_amdgcn_exp2f(-fabsf(z1)));
                        const bool in0 = kp < qpos, in1 = kp + 32 < qpos;
                        lr0[r] = in0 ? -sp0 : 0.f; lr1[r] = in1 ? -sp1 : 0.f;
                        p0[r] = in0 ? z0 - sp0 : -INFINITY; p1[r] = in1 ? z1 - sp1 : -INFINITY;
                        g0 += lr0[r]; g1 += lr1[r]; }
                    gs[0][rq] = g0; gs[1][rq] = g1; }
#pragma unroll
                for (int kb = 0; kb < 2; ++kb)
#pragma unroll
                    for (int rq = 0; rq < 4; ++rq) og[kb][rq] = other_half(gs[kb][rq], hi);
                float T = 0.f;
#pragma unroll
                for (int kb = 1; kb >= 0; --kb)
#pragma unroll
                    for (int rq = 3; rq >= 0; --rq) {
                        float run = Rrun + T + (hi == 0 ? og[kb][rq] : 0.f);
#pragma unroll
                        for (int i = 3; i >= 0; --i) { const int r = 4 * rq + i;
                            if (kb) { const float wgt = __builtin_amdgcn_exp2f(p1[r] + run); run += lr1[r]; p1[r] = wgt; }
                            else { const float wgt = __builtin_amdgcn_exp2f(p0[r] + run); run += lr0[r]; p0[r] = wgt; } }
                        T += gs[kb][rq] + og[kb][rq];
                    }
                Rrun += T;
            }
#pragma unroll
            for (int ks = 0; ks < 4; ++ks) { u32x4 o;
#pragma unroll
                for (int i = 0; i < 4; ++i) { const int r = 8 * (ks & 1) + 2 * i; o[i] = (ks >> 1) ? pk2(p1[r], p1[r + 1]) : pk2(p0[r], p0[r + 1]); }
                pf[ks] = __builtin_bit_cast(bf16x8, o); }
#pragma unroll
            for (int ks = 0; ks < 4; ++ks) {
                const LAS bf16_t* vb = Vt + (16 * ks + 4 * hi + ((lane & 15) >> 2)) * 72 + 16 * ((lane >> 4) & 1) + 4 * (lane & 3);
                const s16x4 v0a = __builtin_amdgcn_ds_read_tr16_b64_v4i16((LAS s16x4*)(vb)), v0b = __builtin_amdgcn_ds_read_tr16_b64_v4i16((LAS s16x4*)(vb + 8 * 72));
                const s16x4 v1a = __builtin_amdgcn_ds_read_tr16_b64_v4i16((LAS s16x4*)(vb + 32)), v1b = __builtin_amdgcn_ds_read_tr16_b64_v4i16((LAS s16x4*)(vb + 8 * 72 + 32));
                bf16x8 a0, a1;
#pragma unroll
                for (int e = 0; e < 4; ++e) { a0[e] = v0a[e]; a0[4 + e] = v0b[e]; a1[e] = v1a[e]; a1[4 + e] = v1b[e]; }
                __builtin_amdgcn_s_setprio(1); O0 = MFMA32(a0, pf[ks], O0); O1 = MFMA32(a1, pf[ks], O1); __builtin_amdgcn_s_setprio(0);
            }
        }
        if (more) attn_store<SB>(lds, buf ^ 1, tid, x);
        if (SB) {
            const bool wdone = __builtin_amdgcn_ballot_w64((j <= jd) && (Rrun < -160.f)) == ~0ull;
            LAS unsigned* votes = (LAS unsigned*)(lds + 37376) + (it & 1) * 8;
            if (lane == 0) votes[w] = wdone ? 1u : 0u;
            __syncthreads();
            const u32x4 va = *(const LAS u32x4*)votes, vb = *(const LAS u32x4*)(votes + 4);
            if ((va[0] & va[1] & va[2] & va[3] & vb[0] & vb[1] & vb[2] & vb[3]) != 0u) break;
        }
        else __syncthreads();
    }
    if (!SB) { const float lt = lrun + other_half(lrun, hi); const float inv = 1.f / lt;
#pragma unroll
        for (int r = 0; r < 16; ++r) { O0[r] *= inv; O1[r] *= inv; } }
    bf16_t* orow = WSP(bf16_t, OFF_YC) + (tokb + qpos) * 1024 + OC + h * 64 + 4 * hi;
#pragma unroll
    for (int rq = 0; rq < 4; ++rq) {
        u32x2 t0; t0[0] = pk2(O0[4 * rq], O0[4 * rq + 1]); t0[1] = pk2(O0[4 * rq + 2], O0[4 * rq + 3]); *(u32x2*)(orow + 8 * rq) = t0;
        u32x2 t1; t1[0] = pk2(O1[4 * rq], O1[4 * rq + 1]); t1[1] = pk2(O1[4 * rq + 2], O1[4 * rq + 3]); *(u32x2*)(orow + 32 + 8 * rq) = t1;
    }
    __syncthreads();
}

#define XB_TMO      128
#define XB_XCNT(j)  (256  + 64 * (j))
#define XB_XSUB(j)  (1280 + 64 * (j))
#define XB_XGEN(j)  (2304 + 64 * (j))
#define XB_TOP      3328
#define XB_TOPGEN   3392
#define XCD_BAR_WORDS 3456
#define XB_SPIN_CAP (1u << 18)
__device__ __forceinline__ unsigned xb_ld(unsigned* p)              { return __hip_atomic_load(p, __ATOMIC_RELAXED, __HIP_MEMORY_SCOPE_AGENT); }
__device__ __forceinline__ unsigned xb_add(unsigned* p, unsigned v) { return __hip_atomic_fetch_add(p, v, __ATOMIC_RELAXED, __HIP_MEMORY_SCOPE_AGENT); }
__device__ __forceinline__ unsigned xb_xcc_id() { return (unsigned)__builtin_amdgcn_s_getreg((3 << 11) | 20) & 0xFu; }
#define XB_SPIN(cond, bar) do { unsigned _sp = 0; while (cond) { __builtin_amdgcn_s_sleep(1); \
    if ((++_sp & 255u) == 0u) { if (xb_ld(&(bar)[XB_TMO])) break; if (_sp > XB_SPIN_CAP) { atomicAdd(&(bar)[XB_TMO], 1u); break; } } } } while (0)
struct XcdBarrier { unsigned* bar; unsigned x; volatile LAS unsigned* st; };
__device__ __forceinline__ XcdBarrier xcd_barrier_post(unsigned* bar, volatile LAS unsigned* st) {
    XcdBarrier b; b.bar = bar; b.x = xb_xcc_id(); b.st = st;
    if (threadIdx.x == 0) (void)xb_add(&bar[XB_XCNT(b.x)], 1u);
    return b;
}
__device__ __forceinline__ void xcd_barrier_complete(unsigned* bar, unsigned x, unsigned& nloc, unsigned& nx) {
    const unsigned G = gridDim.x * gridDim.y * gridDim.z;
    unsigned sum, cnt, mine, sp = 0u;
    for (;;) {
        sum = 0u; cnt = 0u; mine = 0u;
#pragma unroll
        for (unsigned j = 0; j < 16; ++j) { const unsigned c = xb_ld(&bar[XB_XCNT(j)]); sum += c; cnt += (c > 0u) ? 1u : 0u; mine = (j == x) ? c : mine; }
        if (sum == G) break;
        __builtin_amdgcn_s_sleep(1);
        if ((++sp & 255u) == 0u) { if (xb_ld(&bar[XB_TMO])) break; if (sp > XB_SPIN_CAP) { atomicAdd(&bar[XB_TMO], 1u); break; } }
    }
    nloc = mine > 0u ? mine : 1u; nx = cnt > 0u ? cnt : 1u;
}
__device__ __forceinline__ void xcd_barrier(const XcdBarrier& b) {
    asm volatile("s_waitcnt vmcnt(0)" ::: "memory");
    __syncthreads();
    if (threadIdx.x == 0) {
        unsigned* bar = b.bar;
        __builtin_amdgcn_s_waitcnt(0);
        unsigned nloc = b.st[0], nx = b.st[1];
        if (nloc == 0u) { xcd_barrier_complete(bar, b.x, nloc, nx); b.st[0] = nloc; b.st[1] = nx; }
        const unsigned old = xb_add(&bar[XB_XSUB(b.x)], 1u);
        const unsigned gen = old / nloc;
        if (old + 1u == (gen + 1u) * nloc) {
            __builtin_amdgcn_fence(__ATOMIC_RELEASE, "agent");
            asm volatile("s_waitcnt vmcnt(0)" ::: "memory");
            const unsigned og = xb_add(&bar[XB_TOP], 1u);
            const unsigned tg = og / nx;
            if (og + 1u == (tg + 1u) * nx) xb_add(&bar[XB_TOPGEN], 1u);
            else XB_SPIN(xb_ld(&bar[XB_TOPGEN]) == tg, bar);
            __builtin_amdgcn_fence(__ATOMIC_ACQUIRE, "agent");
            xb_add(&bar[XB_XGEN(b.x)], 1u);
            asm volatile("s_waitcnt vmcnt(0)" ::: "memory");
        } else {
            XB_SPIN(xb_ld(&bar[XB_XGEN(b.x)]) == gen, bar);
            __builtin_amdgcn_fence(__ATOMIC_ACQUIRE, "agent");
            asm volatile("s_waitcnt vmcnt(0)" ::: "memory");
        }
    }
    __syncthreads();
}

#ifndef REP_K
#define REP_K -2
#endif
#ifndef MK_LAUNCHES
#define MK_LAUNCHES 1
#endif
__global__ void __launch_bounds__(512, 2) fwd_megakernel(Params P0, int ph_lo, int ph_hi) {
    extern __shared__ __attribute__((aligned(16))) unsigned char smem[];
    __shared__ int s_task;
    __shared__ unsigned xb_st[2];
    LAS unsigned char* lds = (LAS unsigned char*)smem;
    const int wave0 = __builtin_amdgcn_readfirstlane(threadIdx.x >> 6), G = gridDim.x, c = blockIdx.x, NGW = G * 8;
    __builtin_assume(G >= 1 && G <= 256 && c >= 0 && c < 256);
    if (threadIdx.x == 0) { xb_st[0] = 0u; xb_st[1] = 0u; }
    __syncthreads();
    const XcdBarrier xb = xcd_barrier_post((unsigned*)(P0.ws + OFF_BAR), (volatile LAS unsigned*)xb_st);
#define TID() ({ int t_ = (int)__builtin_amdgcn_mbcnt_hi(~0u, __builtin_amdgcn_mbcnt_lo(~0u, 0u)); asm volatile("" : "+v"(t_)); t_ | (wave0 << 6); })
#define PHASE_IDS() const int tid = TID(), lane = tid & 63, wave = tid >> 6, gw = c * 8 + wave; (void)lane; (void)gw
#pragma unroll 1
    for (int phx = ph_lo * 2; phx < ph_hi * 2; ++phx) {
        const Params& P = P0;
        unsigned* ctr = WSP(unsigned, OFF_CTR);
        const int ph = phx >> 1, rep = phx & 1;
        const int L = ph == 0 ? 0 : (ph - 1) / 10, k = ph == 0 ? -1 : (ph - 1) % 10;
        if (rep == 1 && k != REP_K) continue;
        if (ph == 0) {
            PHASE_IDS();
            if (c == 0 && tid < 64) ctr[tid] = 0u;
            for (int t = c; t < WCONV_TASKS; t += G) wconv_task(P, 0, t, (LAS float*)lds, tid);
            for (int t = c; t < MTOK * 1024 / 4096; t += G) cvt_task(P.in[IX], WSP(bf16_t, OFF_HB), t, tid);
        } else if (k == 0) {
#ifndef NO_G1
            SchedG1 S{P, G, c}; EpiG1 E{P}; pg8::gemm_phase(lds, S, E, TID());
#endif
        } else if (k == 1) {
            PHASE_IDS();
#ifndef NO_PREP
            for (int t = c; t < MTOK / 32; t += G) rwkv_prep(P, L, t, lds, tid);
#endif
#ifndef NO_S51
            for (int t = gw; t < NB * 16 * 16; t += NGW) s5_pass1(P, L, t, lane);
#endif
            for (int t = gw; t < NB * 64; t += NGW) cl_task(P, L, t, lane);
        } else if (k == 2) {
            PHASE_IDS();
            for (;;) {
                if (tid == 0) s_task = (int)atomicAdd(ctr + L * 2 + rep, 1u);
                __syncthreads();
                int t = s_task;
                __syncthreads();
                if (t >= 128 + 512 + 256 + 512) break;
                { const int a_ = t - 128; if (a_ >= 224 && a_ < 224 + 256) t = 128 + 512 + (a_ - 224); else if (a_ >= 224 + 256 && a_ < 512 + 256) t = 128 + 224 + (a_ - 224 - 256); }
#ifdef REP_MASK
                if (rep == 1) { const int cls = t < 128 ? 1 : t < 128 + 512 ? 2 : t < 128 + 512 + 256 ? 4 : 8; if (!(cls & REP_MASK)) continue; }
#endif
#ifndef NO_SCAN
                if (t < 128) rwkv_scan(P, t, lds, tid); else
#endif
#ifndef NO_FOX
                if (t < 128 + 512) { const int i = t - 128; attn_unit<false>(P, (i & 31) >> 2, i & 3, 15 - (i >> 5), lds, tid); } else
#endif
#ifndef NO_S53
                if (t < 128 + 512 + 256) s5_pass3(P, L, t - (128 + 512), lds, tid); else
#endif
#ifndef NO_SB
                { const int i = t - (128 + 512 + 256); attn_unit<true>(P, (i & 31) >> 2, i & 3, 15 - (i >> 5), lds, tid); }
#else
                {}
#endif
            }
        } else if (k == 3) {
            PHASE_IDS(); for (int tok = gw; tok < MTOK; tok += NGW) rwkv_post(P, L, (size_t)tok, lane);
        } else if (k == 4) {
#ifndef NO_G2
            SchedG2 S{P, G, c}; EpiG2 E{P}; pg8::gemm_phase(lds, S, E, TID());
#endif
        } else if (k == 5) {
#ifndef NO_G3
            SchedG3 S{P, G, c}; EpiG3 E{P, L == 0 ? P.in[IX] : (const float*)P.out, L == 0 ? (const float*)nullptr : P.in[ILN2G] + (L - 1) * 1024, L == 0 ? (const float*)nullptr : P.in[ILN2B] + (L - 1) * 1024}; pg8::gemm_phase(lds, S, E, TID());
#endif
        } else if (k == 6) {
            PHASE_IDS();
            for (int r = gw; r < MTOK; r += NGW) ln_row(P.out + (size_t)r * 1024, P.in[ILN1G] + L * 1024, P.in[ILN1B] + L * 1024, WSP(bf16_t, OFF_HB) + (size_t)r * 1024, WSP(f32x2, OFF_STAT) + r, false, lane);
            for (int t = c; t < MTOK * 256 / 4096; t += G) cvt_task(P.in[IP] + (size_t)L * MTOK * 256, WSP(bf16_t, OFF_YC), t, tid);
        } else if (k == 7) {
#ifndef NO_G4
            SchedG4 S{P, G, c}; EpiG4 E{P}; pg8::gemm_phase(lds, S, E, TID());
#endif
        } else if (k == 8) {
#ifndef NO_G5
            SchedG5 S{P, G, c}; EpiG5 E{P, P.in[ILN1G] + L * 1024, P.in[ILN1B] + L * 1024}; pg8::gemm_phase(lds, S, E, TID());
#endif
        } else {
            PHASE_IDS();
            for (int r = gw; r < MTOK; r += NGW) ln_row(P.out + (size_t)r * 1024, P.in[ILN2G] + L * 1024, P.in[ILN2B] + L * 1024, L + 1 < DEPTH ? WSP(bf16_t, OFF_HB) + (size_t)r * 1024 : (bf16_t*)nullptr, L + 1 < DEPTH ? WSP(f32x2, OFF_STAT) + r : (f32x2*)nullptr, L + 1 == DEPTH, lane);
            if (L + 1 < DEPTH) { for (int t = c; t < WCONV_TASKS; t += G) wconv_task(P, L + 1, t, (LAS float*)lds, tid); }
        }
        if (phx + 1 < ph_hi * 2) { if (ph_lo < 0) cg::this_grid().sync(); else xcd_barrier(xb); }
    }
}
constexpr int N_PHASES = 1 + 10 * DEPTH;

#ifdef PROBE_PH
__global__ void probe_dump(Params P, int mode) {
    const size_t i = (size_t)blockIdx.x * blockDim.x + threadIdx.x; if (i >= (size_t)MTOK * 1024) return;
    const size_t tok = i >> 10; const int c = (int)(i & 1023);
    float v = 0.f;
    if (mode == 0) { v = bf1(WSP(bf16_t, OFF_PS)[tok * PSLD + c]); }
    else if (mode == 1) { v = bf1(WSP(bf16_t, OFF_PS)[tok * PSLD + 1024 + 768 + c]); if (c >= 1024 - 0) v = 0.f; }
    else if (mode == 2) { v = (c >= 512 && c < 768) ? 0.f : bf1(WSP(bf16_t, OFF_YC)[tok * 1024 + c]); }
    else if (mode == 3) { v = bf1(WSP(bf16_t, OFF_YC)[tok * 1024 + c]); }
    else if (mode == 4) { v = bf1(WSP(bf16_t, OFF_MG)[tok * 1024 + c]); }
    else if (mode == 5) { v = c < 256 ? WSP(float, OFF_RW_DEC)[tok * 256 + c] : c < 512 ? bf1(WSP(bf16_t, OFF_RW_KK)[tok * 256 + c - 256]) : c < 768 ? bf1(WSP(bf16_t, OFF_RW_B)[tok * 256 + c - 512]) : bf1(WSP(bf16_t, OFF_RW_G)[tok * 256 + c - 768]); }
    else if (mode == 6) { v = c < 256 ? ((const float*)(P.ws + OFF_PS + 2048 + tok * (PSLD * 2)))[c] : 0.f; }
    else if (mode == 7) { v = P.out[i]; }
    else if (mode == 10) { v = c < 256 ? bf1(WSP(bf16_t, OFF_RW_KK)[tok * 256 + c]) : c < 512 ? bf1(WSP(bf16_t, OFF_RW_V)[tok * 256 + c - 256]) : c < 768 ? bf1(WSP(bf16_t, OFF_RW_R)[tok * 256 + c - 512]) : 0.f; }
    else if (mode == 12) { v = c < 768 ? bf1(WSP(bf16_t, OFF_YC)[tok * 1024 + c]) : bf1(WTP(WT_RW2)[(i >> 2) & 65535]); }
    else if (mode == 13) { v = c < 256 ? WSP(float, OFF_RW_DEC)[tok * 256 + c] : 0.f; }
    else if (mode == 14) { v = c < 256 ? bf1(WSP(bf16_t, OFF_RW_B)[tok * 256 + c]) : c < 512 ? bf1(WSP(bf16_t, OFF_RW_G)[tok * 256 + c - 256]) : c < 768 ? bf1(WSP(bf16_t, OFF_RW_K)[tok * 256 + c - 512]) : 0.f; }
    else if (mode == 8) { v = bf1(WSP(bf16_t, OFF_PS)[tok * PSLD + 1024 + c]); }
    else if (mode == 9) { v = c < 256 ? bf1(WSP(bf16_t, OFF_RW_R)[tok * 256 + c]) : c < 512 ? bf1(WSP(bf16_t, OFF_RW_K)[tok * 256 + c - 256]) : c < 768 ? bf1(WSP(bf16_t, OFF_RW_V)[tok * 256 + c - 512]) : WSP(float, OFF_RW_DEC)[tok * 256 + c - 768]; }
    P.out[i] = v;
}
#endif
extern "C" void kernel_launch(void* const* d_in, const int* in_sizes, int n_in, void* d_out, int out_size, void* d_ws, size_t ws_size, hipStream_t stream) {
    static int grid = 0;
    if (grid == 0) {
        if (n_in != NIN || out_size != MTOK * 1024 || ws_size < WS_END) { fprintf(stderr, "kernel_launch: unexpected shapes: n_in %d out %d ws %zu (need %zu)\n", n_in, out_size, ws_size, (size_t)WS_END); grid = -1; return; }
        int dev = 0, cus = 0, per_cu = 0;
        (void)hipGetDevice(&dev); (void)hipDeviceGetAttribute(&cus, hipDeviceAttributeMultiprocessorCount, dev);
        if (hipFuncSetAttribute((const void*)fwd_megakernel, hipFuncAttributeMaxDynamicSharedMemorySize, LDS_BYTES) != hipSuccess) { fprintf(stderr, "kernel_launch: hipFuncSetAttribute failed\n"); grid = -1; return; }
        if (hipOccupancyMaxActiveBlocksPerMultiprocessor(&per_cu, (const void*)fwd_megakernel, 512, LDS_BYTES) != hipSuccess || per_cu < 1) { fprintf(stderr, "kernel_launch: occupancy query says %d\n", per_cu); per_cu = 1; }
        (void)hipGetLastError();
        grid = cus * per_cu; if (grid > 256) grid = 256;
        if (grid < 1) grid = -1;
    }
    if (grid < 0) return;
    if (hipMemsetAsync((char*)d_ws + OFF_CTR, 0, 4096 + 16384, stream) != hipSuccess) { fprintf(stderr, "kernel_launch: memset of control words failed\n"); return; }
    Params p{};
    for (int i = 0; i < NIN; ++i) p.in[i] = (const float*)d_in[i];
    p.out = (float*)d_out; p.ws = (unsigned char*)d_ws;
#if MK_LAUNCHES == 1
    int lo = 0, hi = N_PHASES;
    void* args[] = {&p, &lo, &hi};
    hipError_t e = hipLaunchCooperativeKernel((const void*)fwd_megakernel, dim3(grid), dim3(512), args, LDS_BYTES, stream);
    if (e != hipSuccess) fprintf(stderr, "cooperative launch failed: %s (grid %d)\n", hipGetErrorString(e), grid);
#else
#ifdef PROBE_PH
    for (int ph = 0; ph < PROBE_PH; ++ph) hipLaunchKernelGGL(fwd_megakernel, dim3(grid), dim3(512), LDS_BYTES, stream, p, ph, ph + 1);
    hipLaunchKernelGGL(probe_dump, dim3(MTOK * 1024 / 256), dim3(256), 0, stream, p, PROBE_MODE);
#else
    for (int ph = 0; ph < N_PHASES; ++ph) hipLaunchKernelGGL(fwd_megakernel, dim3(grid), dim3(512), LDS_BYTES, stream, p, ph, ph + 1);
#endif
#endif
}
```

```cpp
#include <hip/hip_runtime.h>
#include <hip/hip_cooperative_groups.h>
#include <cstdio>
#include <cstdint>
namespace cg = cooperative_groups;

#define LAS __attribute__((address_space(3)))
typedef unsigned short bf16_t;
typedef short bf16x8 __attribute__((ext_vector_type(8)));
typedef short s16x4 __attribute__((ext_vector_type(4)));
typedef float f32x4 __attribute__((ext_vector_type(4)));
typedef float f32x2 __attribute__((ext_vector_type(2)));
typedef float f32x16 __attribute__((ext_vector_type(16)));
typedef unsigned u32x4 __attribute__((ext_vector_type(4)));
typedef unsigned u32x2 __attribute__((ext_vector_type(2)));

constexpr int DM = 1024, NB = 8, SEQ = 4096, MTOK = NB * SEQ, DEPTH = 2, PLE = 256, BW = 256, DFF = 4096, DIN = 6916;
constexpr int PSLD = 2816;
constexpr float LN_EPS = 1e-5f, GN_EPS = 64e-5f;
constexpr float ALPHA = 1.4142135623730951f;
enum { IX = 0, IP, IW_IN, IS5_LRE, IS5_LIM, IS5_LDT, IS5_BRE, IS5_BIM, IS5_CRE, IS5_CIM, IS5_D, IS5_GLUW, IS5_GLUB, IFOX_B, IRW_MU, IRW_W0, IRW_W2, IRW_A0, IRW_A2,
       IRW_G2, IRW_KK, IRW_KA, IRW_RK, IRW_LNG, IRW_LNB, IW_BR, IW_OUT, ILN1G, ILN1B, IW1, IW2, IPLE_W, IPLE_G, ILN2G, ILN2B, NIN };

constexpr size_t SZ_M1024_BF = (size_t)MTOK * 1024 * 2;
constexpr size_t OFF_YC = 0;
constexpr size_t OFF_PS = OFF_YC + SZ_M1024_BF;
constexpr size_t SZ_PS = (size_t)MTOK * PSLD * 2;
constexpr size_t OFF_RW = OFF_PS + SZ_PS;
constexpr size_t SZ_M256_BF = (size_t)MTOK * 256 * 2;
constexpr size_t OFF_RW_DEC = OFF_RW;
constexpr size_t OFF_RW_R = OFF_RW_DEC + 2 * SZ_M256_BF;
constexpr size_t OFF_RW_K = OFF_RW_R + SZ_M256_BF;
constexpr size_t OFF_RW_V = OFF_RW_K + SZ_M256_BF;
constexpr size_t OFF_RW_KK = OFF_RW_V + SZ_M256_BF;
constexpr size_t OFF_RW_B = OFF_RW_KK + SZ_M256_BF;
constexpr size_t OFF_RW_G = OFF_RW_B + SZ_M256_BF;
constexpr size_t OFF_RW_END = OFF_RW_G + SZ_M256_BF;
constexpr size_t OFF_U = OFF_PS;
constexpr size_t OFF_G5S = OFF_U + (size_t)MTOK * 4096 * 2;
constexpr size_t OFF_G2S = OFF_PS;
constexpr size_t OFF_MG = OFF_RW;
constexpr size_t OFF_HB = OFF_RW_END;
constexpr size_t OFF_WT = OFF_HB + SZ_M1024_BF;
constexpr size_t WT_IN = 0;
constexpr size_t WT_BR = WT_IN + (size_t)DIN * 1024;
constexpr size_t WT_OUT = WT_BR + 4 * 1024 * 256;
constexpr size_t WT_W1 = WT_OUT + 1024 * 1024;
constexpr size_t WT_W2 = WT_W1 + 4096 * 1024;
constexpr size_t WT_PL = WT_W2 + 4096 * 1024;
constexpr size_t WT_PG = WT_PL + 1024 * 256;
constexpr size_t WT_GLU = WT_PG + 1024 * 1024;
constexpr size_t WT_RW2 = WT_GLU + 256 * 256;
constexpr size_t WT_RA2 = WT_RW2 + 256 * 64;
constexpr size_t WT_RG2 = WT_RA2 + 256 * 64;
constexpr size_t WT_END = WT_RG2 + 256 * 128;
constexpr size_t OFF_FL = OFF_WT + WT_END * 2;
constexpr size_t OFF_CL = OFF_FL + (size_t)MTOK * 4 * 4;
constexpr size_t OFF_E256 = OFF_CL + (size_t)MTOK * 4 * 4;
constexpr size_t OFF_L32 = OFF_E256 + (size_t)NB * 16 * 16 * 64 * 8;
constexpr size_t OFF_CTR = OFF_L32 + (size_t)NB * 128 * 16 * 64 * 8;
constexpr size_t OFF_BAR = OFF_CTR + 4096;
constexpr size_t OFF_STAT = OFF_BAR + 16384;
constexpr size_t WS_END = OFF_STAT + (size_t)MTOK * 8;
static_assert(OFF_G5S + (size_t)256 * 131072 <= OFF_RW_END, "G5 scratch must fit in the dead rwkv region");
static_assert(WS_END <= (size_t)536870912, "workspace map exceeds 512 MiB");

constexpr int LDS_BYTES = 131072 + 16384;

typedef __bf16 bf16x2_t __attribute__((ext_vector_type(2)));
__device__ __forceinline__ unsigned pk2(float lo, float hi) { f32x2 v; v[0] = lo; v[1] = hi; bf16x2_t r = __builtin_convertvector(v, bf16x2_t); return __builtin_bit_cast(unsigned, r); }
__device__ __forceinline__ float bflo(unsigned u) { return __uint_as_float(u << 16); }
__device__ __forceinline__ float bfhi(unsigned u) { return __uint_as_float(u & 0xffff0000u); }
__device__ __forceinline__ float bf1(bf16_t u) { return __uint_as_float(((unsigned)u) << 16); }
__device__ __forceinline__ float sigm(float x) { return __builtin_amdgcn_rcpf(1.f + __expf(-x)); }
__device__ __forceinline__ float lane_get(float v, int src_lane) { return __builtin_bit_cast(float, __builtin_amdgcn_ds_bpermute(src_lane << 2, __builtin_bit_cast(int, v))); }
__device__ __forceinline__ float wave_sum(float v, int lane) {
#pragma unroll
    for (int o = 1; o < 64; o <<= 1) v += lane_get(v, lane ^ o);
    return v;
}
__device__ __forceinline__ float rowsum16(float x) {
    x += __builtin_bit_cast(float, __builtin_amdgcn_update_dpp(0, __builtin_bit_cast(int, x), 0x128, 0xf, 0xf, false));
    x += __builtin_bit_cast(float, __builtin_amdgcn_update_dpp(0, __builtin_bit_cast(int, x), 0x124, 0xf, 0xf, false));
    x += __builtin_bit_cast(float, __builtin_amdgcn_update_dpp(0, __builtin_bit_cast(int, x), 0x122, 0xf, 0xf, false));
    x += __builtin_bit_cast(float, __builtin_amdgcn_update_dpp(0, __builtin_bit_cast(int, x), 0x121, 0xf, 0xf, false));
    return x;
}
__device__ __forceinline__ void rowsum16x2(float& a, float& b) {
#define DPP_ROR_(x, c) __builtin_bit_cast(float, __builtin_amdgcn_update_dpp(0, __builtin_bit_cast(int, x), c, 0xf, 0xf, false))
    float ta = DPP_ROR_(a, 0x128), tb = DPP_ROR_(b, 0x128); a += ta; b += tb;
    ta = DPP_ROR_(a, 0x124); tb = DPP_ROR_(b, 0x124); a += ta; b += tb;
    ta = DPP_ROR_(a, 0x122); tb = DPP_ROR_(b, 0x122); a += ta; b += tb;
    ta = DPP_ROR_(a, 0x121); tb = DPP_ROR_(b, 0x121); a += ta; b += tb;
#undef DPP_ROR_
}
__device__ __forceinline__ float other_half(float v, int hi) {
    auto rr = __builtin_amdgcn_permlane32_swap(__float_as_uint(v), __float_as_uint(v), false, false);
    return __uint_as_float(hi ? rr[0] : rr[1]);
}

namespace pg8 {
constexpr int BM = 256, BK = 64, HALF = 128, HTB = HALF * BK * 2, STAGE_BYTES = 8 * HTB, NXCD = 8, WGM = 8;
__device__ __forceinline__ int lds_byte(int r, int c) { const int st = (r >> 4) * 2 + (c >> 5), rr = r & 15, cc = c & 31, ob = rr * 64 + cc * 2; return st * 1024 + (ob ^ (((ob >> 9) & 1) << 5)); }
__device__ __forceinline__ void stage_rc(int b, int& R, int& C) { const int st = b / 1024, sb = b % 1024, swz = sb ^ (((sb >> 9) & 1) << 5); R = (st >> 1) * 16 + swz / 64; C = (st & 1) * 32 + (swz % 64) / 2; }
__device__ __forceinline__ int perm32(int rho) { const int n = rho >> 4, i = rho & 15; return 8 * (i >> 2) + 4 * n + (i & 3); }

struct GUnit { const char* A; const char* B; unsigned lda, ldb; int nt, pm, pn, kind; };

__device__ __forceinline__ void tile_of(int L, int nM, int nN, int& pm, int& pn) {
    const int nwg = nM * nN; int wgid = L;
    { const int q = nwg / NXCD, r = nwg % NXCD, xcd = wgid % NXCD, off = wgid / NXCD; wgid = (xcd < r ? xcd * (q + 1) : r * (q + 1) + (xcd - r) * q) + off; }
    const int nig = WGM * nN, gid = wgid / nig, fm = gid * WGM, gsz = (nM - fm) < WGM ? (nM - fm) : WGM;
    pm = fm + ((wgid % nig) % gsz); pn = (wgid % nig) / gsz;
}

template <class Sched, class Epi>
__device__ __forceinline__ void gemm_phase(LAS unsigned char* lds, const Sched& S, const Epi& E, const int tid) {
    const int wid = __builtin_amdgcn_readfirstlane(tid >> 6), lane = tid & 63, wr = wid >> 2, wc = wid & 3, fr = lane & 15, fq = lane >> 4;
    int sR0, sC0, sR1, sC1; stage_rc(tid * 16, sR0, sC0); stage_rc(tid * 16 + 8192, sR1, sC1);
    const int sRb0 = (sR0 & ~31) + perm32(sR0 & 31), sRb1 = (sR1 & ~31) + perm32(sR1 & 31);
    sC0 *= 2; sC1 *= 2;
    const unsigned ldsw = (unsigned)wid * 1024u;
    const int aoff = lds_byte(wr * 64 + fr, fq * 8), boff = lds_byte(wc * 32 + fr, fq * 8);
#define PG8_SA(b, h) (((b) * 2 + (h)) * HTB)
#define PG8_SB(b, h) ((4 + (b) * 2 + (h)) * HTB)
#define PG8_STAGE_A(bufoff, gbase, ld) do { \
        __builtin_amdgcn_global_load_lds((const unsigned*)((const char*)(gbase) + (unsigned)(sR0 * (ld) + sC0)), (LAS unsigned*)(lds + (bufoff) + ldsw), 16, 0, 0); \
        __builtin_amdgcn_global_load_lds((const unsigned*)((const char*)(gbase) + (unsigned)(sR1 * (ld) + sC1)), (LAS unsigned*)(lds + (bufoff) + ldsw + 8192), 16, 0, 0); } while (0)
#define PG8_STAGE_B(bufoff, gbase, ld) do { \
        __builtin_amdgcn_global_load_lds((const unsigned*)((const char*)(gbase) + (unsigned)(sRb0 * (ld) + sC0)), (LAS unsigned*)(lds + (bufoff) + ldsw), 16, 0, 0); \
        __builtin_amdgcn_global_load_lds((const unsigned*)((const char*)(gbase) + (unsigned)(sRb1 * (ld) + sC1)), (LAS unsigned*)(lds + (bufoff) + ldsw + 8192), 16, 0, 0); } while (0)
#define PG8_LDA(dst, b, h) do { _Pragma("unroll") for (int m = 0; m < 4; ++m) _Pragma("unroll") for (int k = 0; k < 2; ++k) dst[m][k] = *(const LAS bf16x8*)(lds + PG8_SA(b, h) + aoff + m * 2048 + k * 1024); } while (0)
#define PG8_LDB(dst, b, h) do { _Pragma("unroll") for (int n = 0; n < 2; ++n) _Pragma("unroll") for (int k = 0; k < 2; ++k) dst[n][k] = *(const LAS bf16x8*)(lds + PG8_SB(b, h) + boff + n * 2048 + k * 1024); } while (0)
#define PG8_MMA(ai, bj, At, Bt) do { __builtin_amdgcn_s_setprio(1); _Pragma("unroll") for (int m = 0; m < 4; ++m) _Pragma("unroll") for (int n = 0; n < 2; ++n) _Pragma("unroll") for (int k = 0; k < 2; ++k) \
        acc[ai][bj][m][n] = __builtin_amdgcn_mfma_f32_16x16x32_bf16(Bt[n][k], At[m][k], acc[ai][bj][m][n], 0, 0, 0); __builtin_amdgcn_s_setprio(0); } while (0)
#define PG8_WAIT_V(n) asm volatile("s_waitcnt vmcnt(" #n ")" ::: "memory")
#define PG8_WAIT_L(n) asm volatile("s_waitcnt lgkmcnt(" #n ")" ::: "memory")
#define PG8_BAR __builtin_amdgcn_s_barrier()
#define PG8_SCHED __builtin_amdgcn_sched_barrier(0)
    GUnit cur, nxt; int ui = 0;
    if (!S.next(0, cur)) return;
    f32x4 acc[2][2][4][2];
#pragma unroll
    for (int a = 0; a < 2; ++a)
#pragma unroll
        for (int b = 0; b < 2; ++b)
#pragma unroll
            for (int m = 0; m < 4; ++m)
#pragma unroll
                for (int n = 0; n < 2; ++n) acc[a][b][m][n] = (f32x4){0.f, 0.f, 0.f, 0.f};
    bf16x8 At[4][2], B0[2][2], B1[2][2];
    const char* cA = cur.A; const char* cB = cur.B; unsigned clda = cur.lda, cldb = cur.ldb;
    PG8_STAGE_B(PG8_SB(0, 0), cB, cldb); PG8_STAGE_A(PG8_SA(0, 0), cA, clda); PG8_STAGE_B(PG8_SB(0, 1), cB + (size_t)HALF * cldb, cldb); PG8_STAGE_A(PG8_SA(0, 1), cA + (size_t)HALF * clda, clda);
    if (wr == 1) PG8_BAR;
    PG8_WAIT_V(4); PG8_BAR;
    PG8_STAGE_B(PG8_SB(1, 0), cB + 128, cldb); PG8_STAGE_A(PG8_SA(1, 0), cA + 128, clda); PG8_STAGE_B(PG8_SB(1, 1), cB + (size_t)HALF * cldb + 128, cldb);
    PG8_WAIT_V(6); PG8_BAR;
    for (;;) {
        const bool has_next = S.next(ui + 1, nxt);
        const char* nA = has_next ? nxt.A : cA; const char* nB = has_next ? nxt.B : cB;
        const unsigned nlda = has_next ? nxt.lda : clda, nldb = has_next ? nxt.ldb : cldb;
        const int nt = cur.nt;
        for (int t = 0; t < nt; t += 2) {
            const bool last = (t == nt - 2);
            const char* a1 = cA + (size_t)(t + 1) * 128;
            const char* a2 = last ? nA : cA + (size_t)(t + 2) * 128; const char* b2 = last ? nB : cB + (size_t)(t + 2) * 128;
            const char* a3 = a2 + 128; const char* b3 = b2 + 128;
            const unsigned lda2 = last ? nlda : clda, ldb2 = last ? nldb : cldb;
            PG8_LDB(B0, 0, 0); PG8_SCHED; PG8_LDA(At, 0, 0); PG8_STAGE_A(PG8_SA(1, 1), a1 + (size_t)HALF * clda, clda);
            PG8_WAIT_L(8); PG8_BAR; PG8_WAIT_L(0); PG8_MMA(0, 0, At, B0); PG8_BAR; PG8_SCHED;
            PG8_LDB(B1, 0, 1); PG8_STAGE_B(PG8_SB(0, 0), b2, ldb2);
            PG8_BAR; PG8_WAIT_L(0); PG8_MMA(0, 1, At, B1); PG8_BAR;
            PG8_LDA(At, 0, 1); PG8_STAGE_A(PG8_SA(0, 0), a2, lda2);
            PG8_BAR; PG8_WAIT_L(0); PG8_MMA(1, 0, At, B0); PG8_BAR; PG8_SCHED;
            PG8_STAGE_B(PG8_SB(0, 1), b2 + (size_t)HALF * ldb2, ldb2);
            PG8_WAIT_V(6); PG8_BAR; PG8_MMA(1, 1, At, B1); PG8_BAR;
            PG8_LDB(B0, 1, 0); PG8_SCHED; PG8_LDA(At, 1, 0); PG8_STAGE_A(PG8_SA(0, 1), a2 + (size_t)HALF * lda2, lda2);
            PG8_WAIT_L(8); PG8_BAR; PG8_WAIT_L(0); PG8_MMA(0, 0, At, B0); PG8_BAR; PG8_SCHED;
            PG8_LDB(B1, 1, 1); PG8_STAGE_B(PG8_SB(1, 0), b3, ldb2);
            PG8_BAR; PG8_WAIT_L(0); PG8_MMA(0, 1, At, B1); PG8_BAR;
            PG8_LDA(At, 1, 1); PG8_STAGE_A(PG8_SA(1, 0), a3, lda2);
            PG8_BAR; PG8_WAIT_L(0); PG8_MMA(1, 0, At, B0); PG8_BAR; PG8_SCHED;
            PG8_STAGE_B(PG8_SB(1, 1), b3 + (size_t)HALF * ldb2, ldb2);
            PG8_WAIT_V(6); PG8_BAR; PG8_MMA(1, 1, At, B1); PG8_BAR;
        }
        { int fr2 = fr, fq2 = fq, wr2 = wr, wc2 = wc; asm volatile("" : "+v"(fr2), "+v"(fq2), "+s"(wr2), "+s"(wc2)); E(acc, cur, wr2, wc2, fr2, fq2); }
        if (!has_next) break;
#pragma unroll
        for (int a = 0; a < 2; ++a)
#pragma unroll
            for (int b = 0; b < 2; ++b)
#pragma unroll
                for (int m = 0; m < 4; ++m)
#pragma unroll
                    for (int n = 0; n < 2; ++n) acc[a][b][m][n] = (f32x4){0.f, 0.f, 0.f, 0.f};
        cur = nxt; cA = nA; cB = nB; clda = nlda; cldb = nldb; ++ui;
    }
    PG8_WAIT_V(0);
    if (wr == 0) PG8_BAR;
    PG8_BAR;
#undef PG8_SA
#undef PG8_SB
#undef PG8_STAGE_A
#undef PG8_STAGE_B
#undef PG8_LDA
#undef PG8_LDB
#undef PG8_MMA
#undef PG8_WAIT_V
#undef PG8_WAIT_L
#undef PG8_BAR
#undef PG8_SCHED
}
}
using pg8::GUnit;

struct Params { const float* in[NIN]; float* out; unsigned char* ws; };


#define WSP(T, off) ((T*)(P.ws + (off)))
#define WTP(eoff) ((const bf16_t*)(P.ws + OFF_WT) + (eoff))

__device__ __forceinline__ void tr_tile(const float* __restrict__ src, int ld, int k0, int c0, bf16_t* __restrict__ dst, int K, int r0, LAS float* scr, int tid) {
#pragma unroll
    for (int ps = 0; ps < 2; ++ps) {
        const int i = (tid >> 4) + 32 * ps, j4 = (tid & 15) * 4;
        const f32x4 v = *(const f32x4*)(src + (size_t)(k0 + i) * ld + c0 + j4);
        scr[i * 65 + j4 + 0] = v[0]; scr[i * 65 + j4 + 1] = v[1]; scr[i * 65 + j4 + 2] = v[2]; scr[i * 65 + j4 + 3] = v[3];
    }
    __syncthreads();
    { const int j = tid >> 3, i8 = (tid & 7) * 8;
      u32x4 o; o[0] = pk2(scr[(i8 + 0) * 65 + j], scr[(i8 + 1) * 65 + j]); o[1] = pk2(scr[(i8 + 2) * 65 + j], scr[(i8 + 3) * 65 + j]);
      o[2] = pk2(scr[(i8 + 4) * 65 + j], scr[(i8 + 5) * 65 + j]); o[3] = pk2(scr[(i8 + 6) * 65 + j], scr[(i8 + 7) * 65 + j]);
      *(u32x4*)(dst + (size_t)(r0 + j) * K + k0 + i8) = o; }
    __syncthreads();
}
__device__ __forceinline__ void tr_job(const float* src, int ld, int c0, int K, bf16_t* dst, int t, LAS float* scr, int tid) {
    const int nk = K >> 6, kt = t % nk, rt = t / nk;
    tr_tile(src, ld, kt * 64, c0 + rt * 64, dst, K, rt * 64, scr, tid);
}
constexpr int WC_T0 = 16 * 16, WC_T1 = 16 * 28, WC_T2 = 16 * 64, WC_TBR = 4 * 16, WC_TO = 16 * 16, WC_T1M = 16 * 64, WC_T2M = 64 * 16, WC_TPL = 4 * 16, WC_TPG = 16 * 16,
              WC_TGLU = 4 * 4, WC_TRW = 1 * 4, WC_TRG = 2 * 4;
constexpr int WCONV_TASKS = WC_T0 + WC_T1 + WC_T2 + 4 * WC_TBR + WC_TO + WC_T1M + WC_T2M + WC_TPL + WC_TPG + WC_TGLU + 2 * WC_TRW + WC_TRG + 1;
__device__ __forceinline__ void wconv_task(const Params& P, int L, int t, LAS float* scr, int tid) {
    bf16_t* WT = (bf16_t*)(P.ws + OFF_WT);
    const float* w_in = P.in[IW_IN] + (size_t)L * 1024 * DIN;
    if (t < WC_T0) { tr_job(w_in, DIN, 0, 1024, WT + WT_IN, t, scr, tid); return; } t -= WC_T0;
    if (t < WC_T1) { tr_job(w_in, DIN, 1028, 1024, WT + WT_IN + (size_t)1024 * 1024, t, scr, tid); return; } t -= WC_T1;
    if (t < WC_T2) { tr_job(w_in, DIN, 2820, 1024, WT + WT_IN + (size_t)2820 * 1024, t, scr, tid); return; } t -= WC_T2;
    if (t < 4 * WC_TBR) { const int n = t / WC_TBR; tr_job(P.in[IW_BR] + ((size_t)L * 4 + n) * 256 * 1024, 1024, 0, 256, WT + WT_BR + (size_t)n * 1024 * 256, t % WC_TBR, scr, tid); return; } t -= 4 * WC_TBR;
    if (t < WC_TO) { tr_job(P.in[IW_OUT] + (size_t)L * 1024 * 1024, 1024, 0, 1024, WT + WT_OUT, t, scr, tid); return; } t -= WC_TO;
    if (t < WC_T1M) { tr_job(P.in[IW1] + (size_t)L * 1024 * 4096, 4096, 0, 1024, WT + WT_W1, t, scr, tid); return; } t -= WC_T1M;
    if (t < WC_T2M) { tr_job(P.in[IW2] + (size_t)L * 4096 * 1024, 1024, 0, 4096, WT + WT_W2, t, scr, tid); return; } t -= WC_T2M;
    if (t < WC_TPL) { tr_job(P.in[IPLE_W] + (size_t)L * 256 * 1024, 1024, 0, 256, WT + WT_PL, t, scr, tid); return; } t -= WC_TPL;
    if (t < WC_TPG) { tr_job(P.in[IPLE_G] + (size_t)L * 1024 * 1024, 1024, 0, 1024, WT + WT_PG, t, scr, tid); return; } t -= WC_TPG;
    if (t < WC_TGLU) { tr_job(P.in[IS5_GLUW] + (size_t)L * 256 * 256, 256, 0, 256, WT + WT_GLU, t, scr, tid); return; } t -= WC_TGLU;
    if (t < WC_TRW) { tr_job(P.in[IRW_W2] + (size_t)L * 64 * 256, 256, 0, 64, WT + WT_RW2, t, scr, tid); return; } t -= WC_TRW;
    if (t < WC_TRW) { tr_job(P.in[IRW_A2] + (size_t)L * 64 * 256, 256, 0, 64, WT + WT_RA2, t, scr, tid); return; } t -= WC_TRW;
    if (t < WC_TRG) { tr_job(P.in[IRW_G2] + (size_t)L * 128 * 256, 256, 0, 128, WT + WT_RG2, t, scr, tid); return; } t -= WC_TRG;
    for (int e = tid; e < 4096; e += 512) { const int j = e >> 10, k = e & 1023; WT[WT_IN + (size_t)(2816 + j) * 1024 + k] = (bf16_t)(pk2(w_in[(size_t)k * DIN + 1024 + j], 0.f) & 0xffffu); }
}
__device__ __forceinline__ void cvt_task(const float* __restrict__ src, bf16_t* __restrict__ dst, int t, int tid) {
    const size_t e = (size_t)t * 4096 + tid * 8;
    const f32x4 a = *(const f32x4*)(src + e), b = *(const f32x4*)(src + e + 4);
    u32x4 o; o[0] = pk2(a[0], a[1]); o[1] = pk2(a[2], a[3]); o[2] = pk2(b[0], b[1]); o[3] = pk2(b[2], b[3]);
    *(u32x4*)(dst + e) = o;
}

__device__ __forceinline__ void ln_row(float* zrow, const float* __restrict__ g, const float* __restrict__ b, bf16_t* hbrow, f32x2* stat, bool wr32, int lane) {
    f32x4 v[4]; float s = 0.f;
#pragma unroll
    for (int j = 0; j < 4; ++j) { v[j] = *(const f32x4*)(zrow + 4 * lane + 256 * j); s += (v[j][0] + v[j][1]) + (v[j][2] + v[j][3]); }
    const float mean = wave_sum(s, lane) * (1.f / 1024.f); float s2 = 0.f;
#pragma unroll
    for (int j = 0; j < 4; ++j) { v[j] = v[j] - mean; s2 += (v[j][0] * v[j][0] + v[j][1] * v[j][1]) + (v[j][2] * v[j][2] + v[j][3] * v[j][3]); }
    const float rstd = rsqrtf(wave_sum(s2, lane) * (1.f / 1024.f) + LN_EPS);
    if (stat && lane == 0) { f32x2 st; st[0] = mean; st[1] = rstd; *stat = st; }
#pragma unroll
    for (int j = 0; j < 4; ++j) {
        const f32x4 gg = *(const f32x4*)(g + 4 * lane + 256 * j), bb = *(const f32x4*)(b + 4 * lane + 256 * j);
        const f32x4 o = v[j] * rstd * gg + bb;
        if (wr32) *(f32x4*)(zrow + 4 * lane + 256 * j) = o;
        if (hbrow) { u32x2 q; q[0] = pk2(o[0], o[1]); q[1] = pk2(o[2], o[3]); *(u32x2*)(hbrow + 4 * lane + 256 * j) = q; }
    }
}

__device__ __forceinline__ void ln_rows4(float* z, const float* __restrict__ g, const float* __restrict__ b, bf16_t* hb, f32x2* stat, bool wr32, int lane) {
    f32x4 v[4][4]; float s[4];
#pragma unroll
    for (int k = 0; k < 4; ++k)
#pragma unroll
        for (int j = 0; j < 4; ++j) v[k][j] = *(const f32x4*)(z + k * 1024 + 4 * lane + 256 * j);
#pragma unroll
    for (int k = 0; k < 4; ++k) { s[k] = 0.f;
#pragma unroll
        for (int j = 0; j < 4; ++j) s[k] += (v[k][j][0] + v[k][j][1]) + (v[k][j][2] + v[k][j][3]); }
#pragma unroll
    for (int o = 1; o < 64; o <<= 1) { float t[4];
#pragma unroll
        for (int k = 0; k < 4; ++k) t[k] = lane_get(s[k], lane ^ o);
#pragma unroll
        for (int k = 0; k < 4; ++k) s[k] += t[k]; }
    float mean[4], s2[4];
#pragma unroll
    for (int k = 0; k < 4; ++k) { mean[k] = s[k] * (1.f / 1024.f); s2[k] = 0.f;
#pragma unroll
        for (int j = 0; j < 4; ++j) { v[k][j] = v[k][j] - mean[k]; s2[k] += (v[k][j][0] * v[k][j][0] + v[k][j][1] * v[k][j][1]) + (v[k][j][2] * v[k][j][2] + v[k][j][3] * v[k][j][3]); } }
#pragma unroll
    for (int o = 1; o < 64; o <<= 1) { float t[4];
#pragma unroll
        for (int k = 0; k < 4; ++k) t[k] = lane_get(s2[k], lane ^ o);
#pragma unroll
        for (int k = 0; k < 4; ++k) s2[k] += t[k]; }
    f32x4 gg[4], bb[4];
#pragma unroll
    for (int j = 0; j < 4; ++j) { gg[j] = *(const f32x4*)(g + 4 * lane + 256 * j); bb[j] = *(const f32x4*)(b + 4 * lane + 256 * j); }
#pragma unroll
    for (int k = 0; k < 4; ++k) { const float rstd = rsqrtf(s2[k] * (1.f / 1024.f) + LN_EPS);
        if (stat && lane == 0) { f32x2 st; st[0] = mean[k]; st[1] = rstd; stat[k] = st; }
#pragma unroll
        for (int j = 0; j < 4; ++j) {
            const f32x4 o = v[k][j] * rstd * gg[j] + bb[j];
            if (wr32) *(f32x4*)(z + k * 1024 + 4 * lane + 256 * j) = o;
            if (hb) { u32x2 q; q[0] = pk2(o[0], o[1]); q[1] = pk2(o[2], o[3]); *(u32x2*)(hb + k * 1024 + 4 * lane + 256 * j) = q; }
        } }
}

#define EPI_LOOP(u) _Pragma("unroll") for (int ai = 0; ai < 2; ++ai) _Pragma("unroll") for (int m = 0; m < 4; ++m) _Pragma("unroll") for (int bj = 0; bj < 2; ++bj)
#define EPI_ROW(u) ((u).pm * 256 + ai * 128 + wr * 64 + m * 16 + fr)
#define EPI_COL(u) ((u).pn * 256 + bj * 128 + wc * 32 + 8 * fq)
#define EPI_E ((ai * 4 + m) * 2 + bj)
#define EPI_ROW2(u) ((u).pm * 256 + ai * 128 + wr * 64 + m * 16 + fr)
#define EPI_GROUPS _Pragma("unroll") for (int ai = 0; ai < 2; ++ai) _Pragma("unroll") for (int mh = 0; mh < 2; ++mh)
#define EPI_IN_GROUP _Pragma("unroll") for (int mm = 0; mm < 2; ++mm) _Pragma("unroll") for (int bj = 0; bj < 2; ++bj)
#define EPI_GI (mm * 2 + bj)
#define EPI_PAIRS _Pragma("unroll") for (int ai = 0; ai < 2; ++ai) _Pragma("unroll") for (int m = 0; m < 4; ++m)
#define EPI_IN_PAIR _Pragma("unroll") for (int bj = 0; bj < 2; ++bj)

struct SchedG1 { const Params& P; int G, c;
    __device__ __forceinline__ bool next(int i, GUnit& u) const {
        const int L = i * G + c; if (L >= 128 * 12) return false;
        pg8::tile_of(L, 128, 12, u.pm, u.pn);
        u.A = (const char*)(P.ws + OFF_HB) + (size_t)u.pm * 256 * 2048; u.lda = 2048;
        u.B = (const char*)(WTP(WT_IN)) + (size_t)u.pn * 256 * 2048; u.ldb = 2048; u.nt = 16; u.kind = 0; return true; } };
struct EpiG1 { const Params& P;
    __device__ __forceinline__ void operator()(const f32x4 (&acc)[2][2][4][2], const GUnit& u, int wr, int wc, int fr, int fq) const {
        bf16_t* PS = WSP(bf16_t, OFF_PS); float* FL = WSP(float, OFF_FL);
        if (u.pn < 11) {
            const float qs = u.pn == 1 ? 0.18033688011112042f : (u.pn == 8 ? 0.18033688011112042f : 1.0f);
            EPI_LOOP(u) { const f32x4 v0 = acc[ai][bj][m][0] * qs, v1 = acc[ai][bj][m][1] * qs; u32x4 o; o[0] = pk2(v0[0], v0[1]); o[1] = pk2(v0[2], v0[3]); o[2] = pk2(v1[0], v1[1]); o[3] = pk2(v1[2], v1[3]);
                *(u32x4*)(PS + (size_t)EPI_ROW(u) * PSLD + EPI_COL(u)) = o; }
        } else if (wc == 0 && fq == 0) {
#pragma unroll
            for (int ai = 0; ai < 2; ++ai)
#pragma unroll
                for (int m = 0; m < 4; ++m) { const int bj = 0; *(f32x4*)(FL + (size_t)EPI_ROW(u) * 4) = acc[ai][0][m][0]; }
        } } };

struct SchedG2 { const Params& P; int G, c;
    __device__ __forceinline__ bool next(int i, GUnit& u) const {
        const int ti = i >> 3, st = i & 7, n = st >> 1; const int L = ti * G + c; if (L >= 128 * 4) return false;
        pg8::tile_of(L, 128, 4, u.pm, u.pn);
        if (!(st & 1)) { u.A = (const char*)(P.ws + OFF_YC) + (size_t)u.pm * 256 * 2048 + n * 512; u.lda = 2048;
            u.B = (const char*)(WTP(WT_BR)) + ((size_t)n * 1024 + u.pn * 256) * 512; u.ldb = 512; u.nt = 4; u.kind = 0; }
        else { u.A = (const char*)(P.ws + OFF_HB) + (size_t)u.pm * 256 * 2048; u.lda = 2048;
            u.B = (const char*)(WTP(WT_IN)) + ((size_t)2820 + n * 1024 + u.pn * 256) * 2048; u.ldb = 2048; u.nt = 16; u.kind = 1 + n; }
        return true; } };
struct EpiG2 { const Params& P;
    __device__ __forceinline__ void operator()(const f32x4 (&acc)[2][2][4][2], const GUnit& u, int wr, int wc, int fr, int fq) const {
        unsigned char* Sb = P.ws + OFF_G2S + (size_t)blockIdx.x * 393216;
        int fr_ = fr; asm volatile("" : "+v"(fr_));
        const unsigned tl16 = (unsigned)((wr * 4 + wc) * 64 + fq * 16 + fr_) * 16u;
#define G2_S(e) (*(u32x4*)(Sb + ({ unsigned o_ = tl16; asm volatile("" : "+v"(o_)); o_ + (e) * 8192u; })))
#define G2_M(e) (*(f32x4*)(Sb + 131072 + ({ unsigned o_ = tl16; asm volatile("" : "+v"(o_)); o_ + (e) * 8192u; })))
        bf16_t* MG = WSP(bf16_t, OFF_MG);
        if (u.kind == 0) {
            EPI_LOOP(u) { const f32x4 v0 = acc[ai][bj][m][0], v1 = acc[ai][bj][m][1]; u32x4 o; o[0] = pk2(v0[0], v0[1]); o[1] = pk2(v0[2], v0[3]); o[2] = pk2(v1[0], v1[1]); o[3] = pk2(v1[2], v1[3]);
                G2_S(EPI_E) = o; }
        } else {
            const int n = u.kind - 1;
#define G2_GATE_T0T1 const f32x4 g0 = acc[ai][bj][m][0], g1 = acc[ai][bj][m][1]; const u32x4 s = sv[EPI_GI]; f32x4 t0, t1; \
                    t0[0] = sigm(g0[0]) * bflo(s[0]); t0[1] = sigm(g0[1]) * bfhi(s[0]); t0[2] = sigm(g0[2]) * bflo(s[1]); t0[3] = sigm(g0[3]) * bfhi(s[1]); \
                    t1[0] = sigm(g1[0]) * bflo(s[2]); t1[1] = sigm(g1[1]) * bfhi(s[2]); t1[2] = sigm(g1[2]) * bflo(s[3]); t1[3] = sigm(g1[3]) * bfhi(s[3]);
#define G2_MB(e) (*(u32x4*)(Sb + 131072 + ({ unsigned o_ = tl16; asm volatile("" : "+v"(o_)); o_ + (e) * 8192u; })))
#define G2_ADDM const u32x4 mq = mv[EPI_GI]; t0[0] += bflo(mq[0]); t0[1] += bfhi(mq[0]); t0[2] += bflo(mq[1]); t0[3] += bfhi(mq[1]); t1[0] += bflo(mq[2]); t1[1] += bfhi(mq[2]); t1[2] += bflo(mq[3]); t1[3] += bfhi(mq[3]);
#define G2_PACK u32x4 o; o[0] = pk2(t0[0], t0[1]); o[1] = pk2(t0[2], t0[3]); o[2] = pk2(t1[0], t1[1]); o[3] = pk2(t1[2], t1[3]);
            if (n == 0) {
                EPI_GROUPS { u32x4 sv[4];
                    EPI_IN_GROUP { const int m = 2 * mh + mm; sv[EPI_GI] = G2_S(EPI_E); }
                    EPI_IN_GROUP { const int m = 2 * mh + mm; G2_GATE_T0T1 G2_PACK G2_MB(EPI_E) = o; }
                    __builtin_amdgcn_sched_barrier(0); }
            } else if (n < 3) {
                EPI_PAIRS { u32x4 sv[2], mv[2];
                    EPI_IN_PAIR { sv[bj] = G2_S(EPI_E); mv[bj] = G2_MB(EPI_E); }
                    EPI_IN_PAIR { const int mm = 0; G2_GATE_T0T1 G2_ADDM G2_PACK G2_MB(EPI_E) = o; }
                    __builtin_amdgcn_sched_barrier(0); }
            } else {
                EPI_PAIRS { u32x4 sv[2], mv[2];
                    EPI_IN_PAIR { sv[bj] = G2_S(EPI_E); mv[bj] = G2_MB(EPI_E); }
                    EPI_IN_PAIR { const int mm = 0; G2_GATE_T0T1 G2_ADDM G2_PACK *(u32x4*)(MG + (size_t)EPI_ROW(u) * 1024 + EPI_COL(u)) = o; }
                    __builtin_amdgcn_sched_barrier(0); }
            }
        } } };

struct SchedG3 { const Params& P; int G, c;
    __device__ __forceinline__ bool next(int i, GUnit& u) const {
        const int L = i * G + c; if (L >= 128 * 4) return false;
        pg8::tile_of(L, 128, 4, u.pm, u.pn);
        u.A = (const char*)(P.ws + OFF_MG) + (size_t)u.pm * 256 * 2048; u.lda = 2048;
        u.B = (const char*)(WTP(WT_OUT)) + (size_t)u.pn * 256 * 2048; u.ldb = 2048; u.nt = 16; u.kind = 0; return true; } };
#define LN_APPLY(zv, st, gv, bv) (((zv) - (st)[0]) * (st)[1] * (gv) + (bv))
struct EpiG3 { const Params& P; const float* hsrc; const float* lng; const float* lnb;
    __device__ __forceinline__ void operator()(const f32x4 (&acc)[2][2][4][2], const GUnit& u, int wr, int wc, int fr, int fq) const {
        if (lng == nullptr) {
            EPI_GROUPS {
                f32x4 ha[4], hb4[4];
                EPI_IN_GROUP { const int m = 2 * mh + mm; const size_t o = (size_t)EPI_ROW(u) * 1024 + EPI_COL(u); ha[EPI_GI] = *(const f32x4*)(hsrc + o); hb4[EPI_GI] = *(const f32x4*)(hsrc + o + 4); }
                EPI_IN_GROUP { const int m = 2 * mh + mm; const size_t o = (size_t)EPI_ROW(u) * 1024 + EPI_COL(u);
                    *(f32x4*)(P.out + o) = ha[EPI_GI] * ALPHA + acc[ai][bj][m][0]; *(f32x4*)(P.out + o + 4) = hb4[EPI_GI] * ALPHA + acc[ai][bj][m][1]; }
                __builtin_amdgcn_sched_barrier(0); }
        } else {
            const f32x2* STAT = WSP(f32x2, OFF_STAT);
            EPI_PAIRS {
                const int row = EPI_ROW2(u); const f32x2 st = STAT[row];
                f32x4 ha[2], hb4[2], g0[2], g1[2], b0[2], b1[2];
                EPI_IN_PAIR { const int col = EPI_COL(u); const size_t o = (size_t)row * 1024 + col; ha[bj] = *(const f32x4*)(hsrc + o); hb4[bj] = *(const f32x4*)(hsrc + o + 4);
                    g0[bj] = *(const f32x4*)(lng + col); g1[bj] = *(const f32x4*)(lng + col + 4); b0[bj] = *(const f32x4*)(lnb + col); b1[bj] = *(const f32x4*)(lnb + col + 4); }
                EPI_IN_PAIR { const size_t o = (size_t)row * 1024 + EPI_COL(u);
                    *(f32x4*)(P.out + o) = LN_APPLY(ha[bj], st, g0[bj], b0[bj]) * ALPHA + acc[ai][bj][m][0]; *(f32x4*)(P.out + o + 4) = LN_APPLY(hb4[bj], st, g1[bj], b1[bj]) * ALPHA + acc[ai][bj][m][1]; }
                __builtin_amdgcn_sched_barrier(0); }
        } } };

struct SchedG4 { const Params& P; int G, c;
    __device__ __forceinline__ bool next(int i, GUnit& u) const {
        const int L = i * G + c; if (L >= 128 * 16) return false;
        pg8::tile_of(L, 128, 16, u.pm, u.pn);
        u.A = (const char*)(P.ws + OFF_HB) + (size_t)u.pm * 256 * 2048; u.lda = 2048;
        u.B = (const char*)(WTP(WT_W1)) + (size_t)u.pn * 256 * 2048; u.ldb = 2048; u.nt = 16; u.kind = 0; return true; } };
struct EpiG4 { const Params& P;
    __device__ __forceinline__ void operator()(const f32x4 (&acc)[2][2][4][2], const GUnit& u, int wr, int wc, int fr, int fq) const {
        bf16_t* U = WSP(bf16_t, OFF_U);
        EPI_LOOP(u) { f32x4 v0 = acc[ai][bj][m][0], v1 = acc[ai][bj][m][1];
#pragma unroll
            for (int j = 0; j < 4; ++j) { const float a = fmaxf(v0[j], 0.f), b = fmaxf(v1[j], 0.f); v0[j] = a * a; v1[j] = b * b; }
            u32x4 o; o[0] = pk2(v0[0], v0[1]); o[1] = pk2(v0[2], v0[3]); o[2] = pk2(v1[0], v1[1]); o[3] = pk2(v1[2], v1[3]);
            *(u32x4*)(U + (size_t)EPI_ROW(u) * 4096 + EPI_COL(u)) = o; } } };

struct SchedG5 { const Params& P; int G, c;
    __device__ __forceinline__ bool next(int i, GUnit& u) const {
        const int ti = i / 3, st = i % 3; const int L = ti * G + c; if (L >= 128 * 4) return false;
        pg8::tile_of(L, 128, 4, u.pm, u.pn); u.kind = st;
        if (st == 0) { u.A = (const char*)(P.ws + OFF_YC) + (size_t)u.pm * 256 * 512; u.lda = 512; u.B = (const char*)(WTP(WT_PL)) + (size_t)u.pn * 256 * 512; u.ldb = 512; u.nt = 4; }
        else if (st == 1) { u.A = (const char*)(P.ws + OFF_HB) + (size_t)u.pm * 256 * 2048; u.lda = 2048; u.B = (const char*)(WTP(WT_PG)) + (size_t)u.pn * 256 * 2048; u.ldb = 2048; u.nt = 16; }
        else { u.A = (const char*)(P.ws + OFF_U) + (size_t)u.pm * 256 * 8192; u.lda = 8192; u.B = (const char*)(WTP(WT_W2)) + (size_t)u.pn * 256 * 8192; u.ldb = 8192; u.nt = 64; }
        return true; } };
struct EpiG5 { const Params& P; const float* lng; const float* lnb;
    __device__ __forceinline__ void operator()(const f32x4 (&acc)[2][2][4][2], const GUnit& u, int wr, int wc, int fr, int fq) const {
        unsigned char* Sb = P.ws + OFF_G5S + (size_t)blockIdx.x * 131072;
        int fr_ = fr; asm volatile("" : "+v"(fr_));
        const unsigned tl16 = (unsigned)((wr * 4 + wc) * 64 + fq * 16 + fr_) * 16u;
        if (u.kind == 0) {
            EPI_LOOP(u) { const f32x4 v0 = acc[ai][bj][m][0], v1 = acc[ai][bj][m][1]; u32x4 o; o[0] = pk2(v0[0], v0[1]); o[1] = pk2(v0[2], v0[3]); o[2] = pk2(v1[0], v1[1]); o[3] = pk2(v1[2], v1[3]);
                G2_S(EPI_E) = o; }
        } else if (u.kind == 1) {
            EPI_GROUPS {
                u32x4 sv[4];
                EPI_IN_GROUP { const int m = 2 * mh + mm; sv[EPI_GI] = G2_S(EPI_E); }
                EPI_IN_GROUP { const int m = 2 * mh + mm; const f32x4 g0 = acc[ai][bj][m][0], g1 = acc[ai][bj][m][1]; const u32x4 s = sv[EPI_GI]; u32x4 o;
                    o[0] = pk2(sigm(g0[0]) * bflo(s[0]), sigm(g0[1]) * bfhi(s[0])); o[1] = pk2(sigm(g0[2]) * bflo(s[1]), sigm(g0[3]) * bfhi(s[1]));
                    o[2] = pk2(sigm(g1[0]) * bflo(s[2]), sigm(g1[1]) * bfhi(s[2])); o[3] = pk2(sigm(g1[2]) * bflo(s[3]), sigm(g1[3]) * bfhi(s[3]));
                    G2_S(EPI_E) = o; }
                __builtin_amdgcn_sched_barrier(0); }
        } else {
            const f32x2* STAT = WSP(f32x2, OFF_STAT);
            EPI_PAIRS {
                const int row = EPI_ROW2(u); const f32x2 st = STAT[row];
                u32x4 sv[2]; f32x4 ha[2], hb4[2], g0[2], g1[2], b0[2], b1[2];
                EPI_IN_PAIR { const int col = EPI_COL(u); const size_t o = (size_t)row * 1024 + col; sv[bj] = G2_S(EPI_E); ha[bj] = *(const f32x4*)(P.out + o); hb4[bj] = *(const f32x4*)(P.out + o + 4);
                    g0[bj] = *(const f32x4*)(lng + col); g1[bj] = *(const f32x4*)(lng + col + 4); b0[bj] = *(const f32x4*)(lnb + col); b1[bj] = *(const f32x4*)(lnb + col + 4); }
                EPI_IN_PAIR { const size_t o = (size_t)row * 1024 + EPI_COL(u); const u32x4 s = sv[bj];
                    f32x4 p0, p1; p0[0] = bflo(s[0]); p0[1] = bfhi(s[0]); p0[2] = bflo(s[1]); p0[3] = bfhi(s[1]); p1[0] = bflo(s[2]); p1[1] = bfhi(s[2]); p1[2] = bflo(s[3]); p1[3] = bfhi(s[3]);
                    *(f32x4*)(P.out + o) = LN_APPLY(ha[bj], st, g0[bj], b0[bj]) * ALPHA + acc[ai][bj][m][0] + p0; *(f32x4*)(P.out + o + 4) = LN_APPLY(hb4[bj], st, g1[bj], b1[bj]) * ALPHA + acc[ai][bj][m][1] + p1; }
                __builtin_amdgcn_sched_barrier(0); }
        } } };

struct S5Lane { float lbr, lbi; float bbr[16], bbi[16]; };
__device__ __forceinline__ void s5_setup(const Params& P, int L, int g, int p, S5Lane& s) {
    const float dt = expf(P.in[IS5_LDT][L * 16 + g]);
    const float lr = P.in[IS5_LRE][(L * 16 + g) * 64 + p], li = P.in[IS5_LIM][(L * 16 + g) * 64 + p];
    const float mag = expf(lr * dt), ang = li * dt;
    s.lbr = mag * cosf(ang); s.lbi = mag * sinf(ang);
    const float den = lr * lr + li * li, nr = s.lbr - 1.0f;
    const float fre = (nr * lr + s.lbi * li) / den, fim = (s.lbi * lr - nr * li) / den;
    const float* br = P.in[IS5_BRE] + ((size_t)(L * 16 + g) * 64 + p) * 16; const float* bi = P.in[IS5_BIM] + ((size_t)(L * 16 + g) * 64 + p) * 16;
#pragma unroll
    for (int q = 0; q < 4; ++q) { const f32x4 a = *(const f32x4*)(br + 4 * q), b = *(const f32x4*)(bi + 4 * q);
#pragma unroll
        for (int j = 0; j < 4; ++j) { s.bbr[4 * q + j] = fre * a[j] - fim * b[j]; s.bbi[4 * q + j] = fre * b[j] + fim * a[j]; } }
}
#define S5_STEP(s, wq, xr, xi) do { float bur = 0.f, bui = 0.f; \
    _Pragma("unroll") for (int q = 0; q < 8; ++q) { const float u0 = bflo(wq[q]), u1 = bfhi(wq[q]); \
        bur = fmaf(s.bbr[2 * q], u0, bur); bui = fmaf(s.bbi[2 * q], u0, bui); bur = fmaf(s.bbr[2 * q + 1], u1, bur); bui = fmaf(s.bbi[2 * q + 1], u1, bui); } \
    const float nxr = s.lbr * xr - s.lbi * xi + bur, nxi = s.lbr * xi + s.lbi * xr + bui; xr = nxr; xi = nxi; } while (0)

__device__ __forceinline__ void s5_pass1(const Params& P, int L, int task, int lane) {
    const int g = task & 15, C = (task >> 4) & 15, b = task >> 8;
    S5Lane s; s5_setup(P, L, g, lane, s);
    const bf16_t* PS = WSP(bf16_t, OFF_PS);
    f32x2* L32 = WSP(f32x2, OFF_L32); f32x2* E256 = WSP(f32x2, OFF_E256);
    float xr = 0.f, xi = 0.f;
    const size_t tok0 = (size_t)b * SEQ + C * 256;
    for (int sub = 0; sub < 4; ++sub) {
        const u32x4* src = (const u32x4*)(PS + (tok0 + sub * 64 + lane) * PSLD + g * 16);
        const u32x4 wa = src[0], wb = src[1];
        for (int t = 0; t < 64; ++t) {
            unsigned wq[8];
#pragma unroll
            for (int q = 0; q < 4; ++q) { wq[q] = __builtin_amdgcn_readlane(wa[q], t); wq[4 + q] = __builtin_amdgcn_readlane(wb[q], t); }
            S5_STEP(s, wq, xr, xi);
            if ((t & 31) == 31) { f32x2 o; o[0] = xr; o[1] = xi; L32[(((size_t)b * 128 + C * 8 + sub * 2 + (t >> 5)) * 16 + g) * 64 + lane] = o; }
        }
    }
    { f32x2 o; o[0] = xr; o[1] = xi; E256[(((size_t)b * 16 + C) * 16 + g) * 64 + lane] = o; }
}
__device__ __forceinline__ void cmul(float& ar, float& ai, float br, float bi) { const float r = ar * br - ai * bi, i = ar * bi + ai * br; ar = r; ai = i; }
__device__ __forceinline__ float gelu_tanh(float x) { return 0.5f * x * (1.f + tanhf(0.7978845608028654f * (x + 0.044715f * x * x * x))); }

__device__ __forceinline__ void s5_pass3(const Params& P, int L, int task, LAS unsigned char* lds, int tid) {
    const int lane = tid & 63, w = tid >> 6, b = task >> 5, c128 = task & 31, C = c128 >> 1, j0 = (c128 & 1) * 4;
    LAS bf16_t* Xs = (LAS bf16_t*)lds + w * (32 * 136); LAS bf16_t* Yg = (LAS bf16_t*)(lds + 69632);
    const bf16_t* PS = WSP(bf16_t, OFF_PS); const f32x2* L32 = WSP(f32x2, OFF_L32); const f32x2* E256 = WSP(f32x2, OFF_E256);
    const int h = lane & 15, quad = lane >> 4;
    const size_t tokb = (size_t)b * SEQ + c128 * 128;
    for (int gi = 0; gi < 2; ++gi) {
        const int g = 2 * w + gi;
        S5Lane s; s5_setup(P, L, g, lane, s);
        float xr = 0.f, xi = 0.f;
        { float pr = s.lbr, pi = s.lbi;
#pragma unroll
          for (int q = 0; q < 5; ++q) cmul(pr, pi, pr, pi);
          float p4r = pr, p4i = pi; cmul(p4r, p4i, p4r, p4i); cmul(p4r, p4i, p4r, p4i);
          float qr = p4r, qi = p4i; cmul(qr, qi, qr, qi);
          f32x2 ev[15];
#pragma unroll
          for (int cc = 0; cc < 15; ++cc) { ev[cc] = (f32x2){0.f, 0.f}; if (cc < C) ev[cc] = E256[(((size_t)b * 16 + cc) * 16 + g) * 64 + lane]; }
          f32x2 el = (f32x2){0.f, 0.f}; if (j0) el = L32[(((size_t)b * 128 + C * 8 + 3) * 16 + g) * 64 + lane];
#pragma unroll
          for (int cc = 0; cc < 15; ++cc) if (cc < C) { cmul(xr, xi, qr, qi); xr += ev[cc][0]; xi += ev[cc][1]; }
          if (j0) { cmul(xr, xi, p4r, p4i); xr += el[0]; xi += el[1]; } }
        bf16x8 bfr[4];
#pragma unroll
        for (int ks = 0; ks < 4; ++ks) {
            const float* cp = (ks < 2 ? P.in[IS5_CRE] : P.in[IS5_CIM]) + ((size_t)(L * 16 + g) * 16 + h) * 64 + (ks & 1) * 32 + quad * 8;
            const f32x4 c0 = *(const f32x4*)cp, c1 = *(const f32x4*)(cp + 4); const float sg = ks < 2 ? 1.f : -1.f;
            u32x4 o; o[0] = pk2(sg * c0[0], sg * c0[1]); o[1] = pk2(sg * c0[2], sg * c0[3]); o[2] = pk2(sg * c1[0], sg * c1[1]); o[3] = pk2(sg * c1[2], sg * c1[3]);
            bfr[ks] = __builtin_bit_cast(bf16x8, o);
        }
        const float dd = P.in[IS5_D][(L * 16 + g) * 16 + h];
        for (int sub = 0; sub < 4; ++sub) {
            const size_t tok0 = tokb + sub * 32;
            const u32x4* src = (const u32x4*)(PS + (tok0 + (lane & 31)) * PSLD + g * 16);
            const u32x4 wa = src[0], wb = src[1];
            LAS bf16_t* Uw = (LAS bf16_t*)(lds + 137216) + w * 512;
            *(LAS u32x4*)(Uw + (lane & 31) * 16) = wa; *(LAS u32x4*)(Uw + (lane & 31) * 16 + 8) = wb;
            for (int t = 0; t < 32; ++t) {
                unsigned wq[8];
#pragma unroll
                for (int q = 0; q < 4; ++q) { wq[q] = __builtin_amdgcn_readlane(wa[q], t); wq[4 + q] = __builtin_amdgcn_readlane(wb[q], t); }
                S5_STEP(s, wq, xr, xi);
                const unsigned pk = pk2(xr, xi);
                Xs[t * 136 + lane] = (bf16_t)(pk & 0xffffu); Xs[t * 136 + 64 + lane] = (bf16_t)(pk >> 16);
            }
#pragma unroll
            for (int tb = 0; tb < 2; ++tb) {
                f32x4 acc = {0.f, 0.f, 0.f, 0.f};
#pragma unroll
                for (int ks = 0; ks < 4; ++ks) { const bf16x8 a = *(const LAS bf16x8*)(Xs + (tb * 16 + h) * 136 + ks * 32 + quad * 8); acc = __builtin_amdgcn_mfma_f32_16x16x32_bf16(a, bfr[ks], acc, 0, 0, 0); }
#pragma unroll
                for (int r = 0; r < 4; ++r) { const int t = tb * 16 + quad * 4 + r;
                    const float uu = bf1(Uw[t * 16 + h]);
                    Yg[(sub * 32 + t) * 264 + g * 16 + h] = (bf16_t)(pk2(gelu_tanh(acc[r] + dd * uu), 0.f) & 0xffffu); }
            }
        }
    }
    __syncthreads();
    {
        bf16_t* YC = WSP(bf16_t, OFF_YC);
#pragma unroll 1
        for (int sub = 0; sub < 4; ++sub) {
            const LAS bf16_t* Ys = Yg + sub * 32 * 264;
            LAS bf16_t* So = (LAS bf16_t*)lds + (sub & 1) * (32 * 264);
            int hl = h; asm volatile("" : "+v"(hl));
#pragma unroll
            for (int nb = 0; nb < 2; ++nb) {
                const int n = 32 * w + 16 * nb + hl; const bf16_t* wrow = WTP(WT_GLU) + (size_t)n * 256 + quad * 8; const float gb = P.in[IS5_GLUB][L * 256 + n];
                f32x4 acc[2] = {{0.f, 0.f, 0.f, 0.f}, {0.f, 0.f, 0.f, 0.f}};
#pragma unroll
                for (int ks = 0; ks < 8; ++ks) { const bf16x8 bb = *(const bf16x8*)(wrow + ks * 32);
#pragma unroll
                    for (int tb = 0; tb < 2; ++tb) { const bf16x8 a = *(const LAS bf16x8*)(Ys + (tb * 16 + h) * 264 + ks * 32 + quad * 8); acc[tb] = __builtin_amdgcn_mfma_f32_16x16x32_bf16(a, bb, acc[tb], 0, 0, 0); } }
#pragma unroll
                for (int tb = 0; tb < 2; ++tb)
#pragma unroll
                    for (int r = 0; r < 4; ++r) { const int t = tb * 16 + quad * 4 + r; const float y = bf1(Ys[t * 264 + n]);
                        So[t * 264 + n] = (bf16_t)(pk2(y * sigm(acc[tb][r] + gb), 0.f) & 0xffffu); }
            }
            __syncthreads();
#pragma unroll
            for (int i = 0; i < 2; ++i) { int tl2 = tid; asm volatile("" : "+v"(tl2)); const int e = tl2 + 512 * i, t = e >> 5, c8 = (e & 31) * 8;
                *(u32x4*)(YC + (tokb + sub * 32 + t) * 1024 + c8) = *(const LAS u32x4*)(So + t * 264 + c8); }
        }
    }
    __syncthreads();
}

__device__ __forceinline__ void cl_task(const Params& P, int L, int task, int lane) {
    const int b = task >> 6, tl = task & 63; const float* FL = WSP(float, OFF_FL); float* CL = WSP(float, OFF_CL);
    const f32x4 f = *(const f32x4*)(FL + ((size_t)b * SEQ + tl * 64 + lane) * 4);
#pragma unroll
    for (int h = 0; h < 4; ++h) {
        const float x = f[h] + P.in[IFOX_B][L * 4 + h];
        float v = fminf(x, 0.f) - log1pf(expf(-fabsf(x)));
#pragma unroll
        for (int o = 1; o < 64; o <<= 1) { const float n = lane_get(v, (lane - o) & 63); if (lane >= o) v += n; }
        CL[((size_t)b * 4 + h) * SEQ + tl * 64 + lane] = v;
    }
}

__device__ __forceinline__ void rwkv_prep(const Params& P, int L, int task, LAS unsigned char* lds, int tid) {
    const int lane = tid & 63, w = tid >> 6; const size_t tok0 = (size_t)task * 32;
    LAS bf16_t* At = (LAS bf16_t*)lds; LAS bf16_t* Aa = (LAS bf16_t*)(lds + 4608); LAS bf16_t* Ag = (LAS bf16_t*)(lds + 9216);
    LAS float* Lw = (LAS float*)(lds + 17920); LAS float* La = (LAS float*)(lds + 51200); LAS float* Lg = (LAS float*)(lds + 84480);
    const bf16_t* PS = WSP(bf16_t, OFF_PS); const float* mu = P.in[IRW_MU] + (size_t)L * 1024;
#pragma unroll
    for (int i = 0; i < 2; ++i) {
        const int e = tid + 512 * i, tl = e >> 5, cg = e & 31, c = cg * 8; const size_t tok = tok0 + tl; const int rc = 768 + c;
        const u32x4 cu = *(const u32x4*)(PS + tok * PSLD + 1024 + rc);
        const bool first = (tok % SEQ) == 0;
        const u32x4 pv = *(const u32x4*)(PS + (tok - (first ? 0 : 1)) * PSLD + 1024 + rc);
        const f32x4 m0 = *(const f32x4*)(mu + rc), m1 = *(const f32x4*)(mu + rc + 4);
        float xs[8];
#pragma unroll
        for (int j = 0; j < 4; ++j) { const float c0 = bflo(cu[j]), c1 = bfhi(cu[j]); const float p0 = first ? 0.f : bflo(pv[j]), p1 = first ? 0.f : bfhi(pv[j]);
            const float ma = j < 2 ? m0[2 * j] : m1[2 * j - 4], mb = j < 2 ? m0[2 * j + 1] : m1[2 * j - 3];
            xs[2 * j] = c0 + (p0 - c0) * ma; xs[2 * j + 1] = c1 + (p1 - c1) * mb; }
        u32x4 o;
        if (c < 64) {
#pragma unroll
            for (int j = 0; j < 4; ++j) o[j] = pk2(1.f - 2.f * __builtin_amdgcn_rcpf(1.f + __expf(2.f * xs[2 * j])), 1.f - 2.f * __builtin_amdgcn_rcpf(1.f + __expf(2.f * xs[2 * j + 1])));
            *(LAS u32x4*)(At + tl * 72 + c) = o;
        } else if (c < 128) {
#pragma unroll
            for (int j = 0; j < 4; ++j) o[j] = pk2(xs[2 * j], xs[2 * j + 1]);
            *(LAS u32x4*)(Aa + tl * 72 + c - 64) = o;
        } else {
#pragma unroll
            for (int j = 0; j < 4; ++j) o[j] = pk2(sigm(xs[2 * j]), sigm(xs[2 * j + 1]));
            *(LAS u32x4*)(Ag + tl * 136 + c - 128) = o;
        }
    }
    __syncthreads();
    {
        const int h = lane & 15, quad = lane >> 4;
#pragma unroll
        for (int nb = 0; nb < 2; ++nb) {
            const int n = 32 * w + 16 * nb + h;
            f32x4 aw[2] = {{0.f, 0.f, 0.f, 0.f}, {0.f, 0.f, 0.f, 0.f}}, aa[2] = {{0.f, 0.f, 0.f, 0.f}, {0.f, 0.f, 0.f, 0.f}}, ag[2] = {{0.f, 0.f, 0.f, 0.f}, {0.f, 0.f, 0.f, 0.f}};
#pragma unroll
            for (int ks = 0; ks < 2; ++ks) {
                const bf16x8 bw = *(const bf16x8*)(WTP(WT_RW2) + (size_t)n * 64 + ks * 32 + quad * 8), ba = *(const bf16x8*)(WTP(WT_RA2) + (size_t)n * 64 + ks * 32 + quad * 8);
#pragma unroll
                for (int tb = 0; tb < 2; ++tb) {
                    aw[tb] = __builtin_amdgcn_mfma_f32_16x16x32_bf16(*(const LAS bf16x8*)(At + (tb * 16 + h) * 72 + ks * 32 + quad * 8), bw, aw[tb], 0, 0, 0);
                    aa[tb] = __builtin_amdgcn_mfma_f32_16x16x32_bf16(*(const LAS bf16x8*)(Aa + (tb * 16 + h) * 72 + ks * 32 + quad * 8), ba, aa[tb], 0, 0, 0); }
            }
#pragma unroll
            for (int ks = 0; ks < 4; ++ks) {
                const bf16x8 bg = *(const bf16x8*)(WTP(WT_RG2) + (size_t)n * 128 + ks * 32 + quad * 8);
#pragma unroll
                for (int tb = 0; tb < 2; ++tb) ag[tb] = __builtin_amdgcn_mfma_f32_16x16x32_bf16(*(const LAS bf16x8*)(Ag + (tb * 16 + h) * 136 + ks * 32 + quad * 8), bg, ag[tb], 0, 0, 0);
            }
#pragma unroll
            for (int tb = 0; tb < 2; ++tb)
#pragma unroll
                for (int r = 0; r < 4; ++r) { const int t = tb * 16 + quad * 4 + r; Lw[t * 260 + n] = aw[tb][r]; La[t * 260 + n] = aa[tb][r]; Lg[t * 260 + n] = ag[tb][r];
                }
        }
    }
    __syncthreads();
    {
        const int tl = tid >> 4, q16 = tid & 15; const size_t tok = tok0 + tl; const bool first = (tok % SEQ) == 0;
        const bf16_t* cur = PS + tok * PSLD + 1024; const bf16_t* prv = PS + (tok - (first ? 0 : 1)) * PSLD + 1024;
        float* DEC = WSP(float, OFF_RW_DEC); bf16_t* RR = WSP(bf16_t, OFF_RW_R); bf16_t* RK = WSP(bf16_t, OFF_RW_K); bf16_t* RV = WSP(bf16_t, OFF_RW_V);
        bf16_t* RKK = WSP(bf16_t, OFF_RW_KK); bf16_t* RB = WSP(bf16_t, OFF_RW_B); bf16_t* RG = WSP(bf16_t, OFF_RW_G);
#define UNPK8(dst, q) do { dst[0] = bflo(q[0]); dst[1] = bfhi(q[0]); dst[2] = bflo(q[1]); dst[3] = bfhi(q[1]); dst[4] = bflo(q[2]); dst[5] = bfhi(q[2]); dst[6] = bflo(q[3]); dst[7] = bfhi(q[3]); } while (0)
#define SHIFT8(xo, off) do { const u32x4 a_ = *(const u32x4*)(cur + (off) + c), b_ = *(const u32x4*)(prv + (off) + c); const f32x4 m0_ = *(const f32x4*)(mu + (off) + c), m1_ = *(const f32x4*)(mu + (off) + c + 4); \
            float cu_[8], pv_[8]; UNPK8(cu_, a_); UNPK8(pv_, b_); _Pragma("unroll") for (int j = 0; j < 8; ++j) xo[j] = cu_[j] + ((first ? 0.f : pv_[j]) - cu_[j]) * (j < 4 ? m0_[j & 3] : m1_[j & 3]); } while (0)
#define PK8(v) ({ u32x4 o_; o_[0] = pk2(v[0], v[1]); o_[1] = pk2(v[2], v[3]); o_[2] = pk2(v[4], v[5]); o_[3] = pk2(v[6], v[7]); o_; })
#pragma unroll
        for (int ps = 0; ps < 2; ++ps) {
            const int hh = 2 * ps + (q16 >> 3), c = hh * 64 + (q16 & 7) * 8;
            float xr[8], xk[8], xv[8];
            SHIFT8(xr, 0); SHIFT8(xk, 256); SHIFT8(xv, 512);
            float w0[8], a0[8], kkw[8], kaw[8], lw[8], la[8], lg[8];
#define LD8G(dst, p) do { const f32x4 a_ = *(const f32x4*)(p), b_ = *(const f32x4*)((p) + 4); _Pragma("unroll") for (int j = 0; j < 4; ++j) { dst[j] = a_[j]; dst[4 + j] = b_[j]; } } while (0)
#define LD8L(dst, p) do { const f32x4 a_ = *(const LAS f32x4*)(p), b_ = *(const LAS f32x4*)((p) + 4); _Pragma("unroll") for (int j = 0; j < 4; ++j) { dst[j] = a_[j]; dst[4 + j] = b_[j]; } } while (0)
            LD8G(w0, P.in[IRW_W0] + L * 256 + c); LD8G(a0, P.in[IRW_A0] + L * 256 + c); LD8G(kkw, P.in[IRW_KK] + L * 256 + c); LD8G(kaw, P.in[IRW_KA] + L * 256 + c);
            LD8L(lw, Lw + tl * 260 + c); LD8L(la, La + tl * 260 + c); LD8L(lg, Lg + tl * 260 + c);
            float dec[8], av[8], kx[8], kn[8]; float ss = 0.f;
#pragma unroll
            for (int j = 0; j < 8; ++j) {
                const float wl = w0[j] + lw[j];
                const float wv = -(fmaxf(-wl, 0.f) + __logf(1.f + __expf(-fabsf(wl)))) - 0.5f;
                dec[j] = __expf(-__expf(wv));
                av[j] = sigm(a0[j] + la[j]);
                kx[j] = xk[j] * kkw[j]; ss += kx[j] * kx[j];
                kn[j] = xk[j] * (1.f + (av[j] - 1.f) * kaw[j]);
            }
            ss += __builtin_bit_cast(float, __builtin_amdgcn_update_dpp(0, __builtin_bit_cast(int, ss), 0xB1, 0xf, 0xf, false));
            ss += __builtin_bit_cast(float, __builtin_amdgcn_update_dpp(0, __builtin_bit_cast(int, ss), 0x4E, 0xf, 0xf, false));
            ss += __builtin_bit_cast(float, __builtin_amdgcn_update_dpp(0, __builtin_bit_cast(int, ss), 0x141, 0xf, 0xf, false));
            const float inv = __builtin_amdgcn_rcpf(fmaxf(__builtin_amdgcn_sqrtf(ss), 1e-12f));
            float kkn[8], bv[8];
#pragma unroll
            for (int j = 0; j < 8; ++j) { kkn[j] = kx[j] * inv; bv[j] = kkn[j] * av[j]; }
            const size_t o = tok * 256 + c;
            { f32x4 d4; d4[0] = dec[0]; d4[1] = dec[1]; d4[2] = dec[2]; d4[3] = dec[3]; *(f32x4*)(DEC + o) = d4; d4[0] = dec[4]; d4[1] = dec[5]; d4[2] = dec[6]; d4[3] = dec[7]; *(f32x4*)(DEC + o + 4) = d4; }
            *(u32x4*)(RR + o) = PK8(xr); *(u32x4*)(RK + o) = PK8(kn); *(u32x4*)(RV + o) = PK8(xv); *(u32x4*)(RKK + o) = PK8(kkn); *(u32x4*)(RB + o) = PK8(bv); *(u32x4*)(RG + o) = PK8(lg);
        }
#undef UNPK8
#undef SHIFT8
#undef PK8
#undef LD8G
#undef LD8L
    }
    __syncthreads();
}

constexpr int RS_BUF = 43008, RS_Y = 2 * RS_BUF;
struct RwLoad { u32x2 r, k, kk, b; f32x4 d; bf16_t v; };
__device__ __forceinline__ void rw_load(const Params& P, int b, int h, int qtr, int chunk, int tid, RwLoad& x) {
    const int t = tid >> 4, c4 = (tid & 15) * 4; const size_t tok = (size_t)b * SEQ + chunk * 32 + t; const size_t o = tok * 256 + h * 64 + c4;
    x.r = *(const u32x2*)(WSP(bf16_t, OFF_RW_R) + o); x.k = *(const u32x2*)(WSP(bf16_t, OFF_RW_K) + o); x.kk = *(const u32x2*)(WSP(bf16_t, OFF_RW_KK) + o);
    x.b = *(const u32x2*)(WSP(bf16_t, OFF_RW_B) + o); x.d = *(const f32x4*)(WSP(float, OFF_RW_DEC) + o);
    x.v = WSP(bf16_t, OFF_RW_V)[tok * 256 + h * 64 + qtr * 16 + (tid & 15)];
}
__device__ __forceinline__ void rw_store(LAS unsigned char* buf, int tid, const RwLoad& x) {
    const int t = tid >> 4, c4 = (tid & 15) * 4;
    f32x4 v; v[0] = bflo(x.r[0]); v[1] = bfhi(x.r[0]); v[2] = bflo(x.r[1]); v[3] = bfhi(x.r[1]); *(LAS f32x4*)(buf + (t * 64 + c4) * 4) = v;
    *(LAS f32x4*)(buf + 8192 + (t * 64 + c4) * 4) = x.d;
    v[0] = bflo(x.k[0]); v[1] = bfhi(x.k[0]); v[2] = bflo(x.k[1]); v[3] = bfhi(x.k[1]); *(LAS f32x4*)(buf + 16384 + (t * 64 + c4) * 4) = v;
    v[0] = bflo(x.kk[0]); v[1] = bfhi(x.kk[0]); v[2] = bflo(x.kk[1]); v[3] = bfhi(x.kk[1]); *(LAS f32x4*)(buf + 24576 + (t * 64 + c4) * 4) = v;
    v[0] = bflo(x.b[0]); v[1] = bfhi(x.b[0]); v[2] = bflo(x.b[1]); v[3] = bfhi(x.b[1]); *(LAS f32x4*)(buf + 32768 + (t * 64 + c4) * 4) = v;
    *(LAS float*)(buf + 40960 + (t * 16 + (tid & 15)) * 4) = bf1(x.v);
}
struct RwStep { f32x4 kk4, w4, k4, b4, r4; float vv; };
__device__ __forceinline__ void rw_read(const LAS unsigned char* buf, int t, int kq, int row, RwStep& s) {
    s.kk4 = *(const LAS f32x4*)(buf + 24576 + (t * 64 + kq * 4) * 4); s.w4 = *(const LAS f32x4*)(buf + 8192 + (t * 64 + kq * 4) * 4);
    s.k4 = *(const LAS f32x4*)(buf + 16384 + (t * 64 + kq * 4) * 4); s.b4 = *(const LAS f32x4*)(buf + 32768 + (t * 64 + kq * 4) * 4);
    s.r4 = *(const LAS f32x4*)(buf + (t * 64 + kq * 4) * 4); s.vv = *(const LAS float*)(buf + 40960 + (t * 16 + row) * 4);
}
struct RwLoad8 { u32x4 r, k, kk, b; f32x4 d0, d1; unsigned v; };
__device__ __forceinline__ void rw_load8(const Params& P, int b, int h, int qtr, int chunk, int lt, RwLoad8& x) {
    const int t = lt >> 3, c8 = (lt & 7) * 8; const size_t tok = (size_t)b * SEQ + chunk * 32 + t; const size_t o = tok * 256 + h * 64 + c8;
    x.r = *(const u32x4*)(WSP(bf16_t, OFF_RW_R) + o); x.k = *(const u32x4*)(WSP(bf16_t, OFF_RW_K) + o); x.kk = *(const u32x4*)(WSP(bf16_t, OFF_RW_KK) + o);
    x.b = *(const u32x4*)(WSP(bf16_t, OFF_RW_B) + o); x.d0 = *(const f32x4*)(WSP(float, OFF_RW_DEC) + o); x.d1 = *(const f32x4*)(WSP(float, OFF_RW_DEC) + o + 4);
    x.v = *(const unsigned*)(WSP(bf16_t, OFF_RW_V) + tok * 256 + h * 64 + qtr * 16 + (lt & 7) * 2);
}
__device__ __forceinline__ void rw_put8(LAS unsigned char* p, const u32x4& q) {
    f32x4 v; v[0] = bflo(q[0]); v[1] = bfhi(q[0]); v[2] = bflo(q[1]); v[3] = bfhi(q[1]); *(LAS f32x4*)p = v;
    v[0] = bflo(q[2]); v[1] = bfhi(q[2]); v[2] = bflo(q[3]); v[3] = bfhi(q[3]); *(LAS f32x4*)(p + 16) = v;
}
__device__ __forceinline__ void rw_store8(LAS unsigned char* buf, int lt, const RwLoad8& x) {
    const int t = lt >> 3, c8 = (lt & 7) * 8; LAS unsigned char* p = buf + (t * 64 + c8) * 4;
    rw_put8(p, x.r); *(LAS f32x4*)(p + 8192) = x.d0; *(LAS f32x4*)(p + 8192 + 16) = x.d1; rw_put8(p + 16384, x.k); rw_put8(p + 24576, x.kk); rw_put8(p + 32768, x.b);
    f32x2 vv; vv[0] = bflo(x.v); vv[1] = bfhi(x.v); *(LAS f32x2*)(buf + 40960 + (t * 16 + (lt & 7) * 2) * 4) = vv;
}
__device__ __forceinline__ void rwkv_scan(const Params& P, int task, LAS unsigned char* lds, int tid) {
    const int lane = tid & 63, w = tid >> 6, qtr = task & 3, h = (task >> 2) & 3, b = task >> 4;
    constexpr int RS_Y2 = 2 * RS_BUF;
    if (w >= 4) {
        const int lt = tid - 256;
        RwLoad8 x;
        rw_load8(P, b, h, qtr, 0, lt, x); rw_store8(lds, lt, x);
        __syncthreads();
        for (int ch = 0; ch < 128; ++ch) {
            if (ch + 1 < 128) rw_load8(P, b, h, qtr, ch + 1, lt, x);
            if (ch > 0) {
                const int t = lt >> 3, r2 = (lt & 7) * 2; const size_t tok = (size_t)b * SEQ + (ch - 1) * 32 + t;
                const f32x2 yy = *(const LAS f32x2*)(lds + RS_Y2 + ((ch - 1) & 1) * 2048 + (t * 16 + r2) * 4);
                *(f32x2*)((char*)(P.ws + OFF_PS + 2048) + tok * (PSLD * 2) + (h * 64 + qtr * 16 + r2) * 4) = yy;
            }
            if (ch + 1 < 128) rw_store8(lds + ((ch + 1) & 1) * RS_BUF, lt, x);
            __syncthreads();
        }
        { const int t = lt >> 3, r2 = (lt & 7) * 2; const size_t tok = (size_t)b * SEQ + 127 * 32 + t;
          const f32x2 yy = *(const LAS f32x2*)(lds + RS_Y2 + (127 & 1) * 2048 + (t * 16 + r2) * 4);
          *(f32x2*)((char*)(P.ws + OFF_PS + 2048) + tok * (PSLD * 2) + (h * 64 + qtr * 16 + r2) * 4) = yy; }
    } else {
        const int kq = lane & 15, row = w * 4 + (lane >> 4);
        f32x2 Sa = {0.f, 0.f}, Sb = {0.f, 0.f};
        __syncthreads();
        for (int ch = 0; ch < 128; ++ch) {
            const LAS unsigned char* buf = lds + (ch & 1) * RS_BUF;
            LAS float* Y = (LAS float*)(lds + RS_Y2 + (ch & 1) * 2048);
            RwStep sa_, sb_, sc_; rw_read(buf, 0, kq, row, sa_); rw_read(buf, 1, kq, row, sb_);
#define LO2(v) ((f32x2){(v)[0], (v)[1]})
#define HI2(v) ((f32x2){(v)[2], (v)[3]})
            float p; { f32x2 tp = Sa * LO2(sa_.kk4); tp = Sb * HI2(sa_.kk4) + tp; p = rowsum16(tp[0] + tp[1]); }
#define RW_STEP(cur, nxt, far, tt) do { \
                rw_read(buf, (tt) + 2 < 32 ? (tt) + 2 : 31, kq, row, far); \
                const f32x2 nsa2 = {-p, -p}, vv2 = {cur.vv, cur.vv}; \
                Sa = Sa * LO2(cur.w4) + (nsa2 * LO2(cur.b4) + vv2 * LO2(cur.k4)); Sb = Sb * HI2(cur.w4) + (nsa2 * HI2(cur.b4) + vv2 * HI2(cur.k4)); \
                f32x2 ty = Sa * LO2(cur.r4), tq = Sa * LO2(nxt.kk4); ty = Sb * HI2(cur.r4) + ty; tq = Sb * HI2(nxt.kk4) + tq; \
                float y = ty[0] + ty[1], q = tq[0] + tq[1]; \
                rowsum16x2(y, q); \
                Y[(tt) * 16 + row] = y; \
                p = q; } while (0)
#pragma unroll 1
            for (int t = 0; t < 30; t += 3) { RW_STEP(sa_, sb_, sc_, t); RW_STEP(sb_, sc_, sa_, t + 1); RW_STEP(sc_, sa_, sb_, t + 2); }
            RW_STEP(sa_, sb_, sc_, 30); RW_STEP(sb_, sc_, sa_, 31);
#undef LO2
#undef HI2
#undef RW_STEP
            __syncthreads();
        }
    }
    __syncthreads();
}

__device__ __forceinline__ void rwkv_post(const Params& P, int L, size_t tok, int lane) {
    const int c = lane * 4, hh = lane >> 4;
    const f32x4 y = *(const f32x4*)((const char*)(P.ws + OFF_PS + 2048) + tok * (PSLD * 2) + c * 4);
    const float mean = rowsum16((y[0] + y[1]) + (y[2] + y[3])) * (1.f / 64.f);
    const f32x4 d = y - mean;
    const float var = rowsum16((d[0] * d[0] + d[1] * d[1]) + (d[2] * d[2] + d[3] * d[3])) * (1.f / 64.f);
    const float rstd = rsqrtf(var + GN_EPS);
    const size_t o = tok * 256 + c;
    const u32x2 r2 = *(const u32x2*)(WSP(bf16_t, OFF_RW_R) + o), k2 = *(const u32x2*)(WSP(bf16_t, OFF_RW_K) + o), v2 = *(const u32x2*)(WSP(bf16_t, OFF_RW_V) + o), g2 = *(const u32x2*)(WSP(bf16_t, OFF_RW_G) + o);
    const float r[4] = {bflo(r2[0]), bfhi(r2[0]), bflo(r2[1]), bfhi(r2[1])}, k[4] = {bflo(k2[0]), bfhi(k2[0]), bflo(k2[1]), bfhi(k2[1])},
                v[4] = {bflo(v2[0]), bfhi(v2[0]), bflo(v2[1]), bfhi(v2[1])}, g[4] = {bflo(g2[0]), bfhi(g2[0]), bflo(g2[1]), bfhi(g2[1])};
    const f32x4 rk = *(const f32x4*)(P.in[IRW_RK] + L * 256 + c), lg = *(const f32x4*)(P.in[IRW_LNG] + L * 256 + c), lb = *(const f32x4*)(P.in[IRW_LNB] + L * 256 + c);
    float bs = 0.f;
#pragma unroll
    for (int j = 0; j < 4; ++j) bs += r[j] * k[j] * rk[j];
    bs = rowsum16(bs);
    float o4[4];
#pragma unroll
    for (int j = 0; j < 4; ++j) o4[j] = (d[j] * rstd * lg[j] + lb[j] + bs * v[j]) * g[j];
    u32x2 t; t[0] = pk2(o4[0], o4[1]); t[1] = pk2(o4[2], o4[3]);
    *(u32x2*)(WSP(bf16_t, OFF_YC) + tok * 1024 + 512 + c) = t;
    (void)hh;
}

#define MFMA32(a, b, c) __builtin_amdgcn_mfma_f32_32x32x16_bf16(a, b, c, 0, 0, 0)
struct TileRegs { u32x4 k, v; float bias; };
template <bool SB>
__device__ __forceinline__ void attn_load(const Params& P, size_t tokb, int h, int j, int tid, float coff, const float* clrow, TileRegs& x) {
    const bf16_t* PS = WSP(bf16_t, OFF_PS); constexpr int KC = SB ? 2304 : 512, VC = SB ? 2560 : 768;
    x.k = *(const u32x4*)(PS + (tokb + 64 * j + (tid >> 3)) * PSLD + KC + h * 64 + (tid & 7) * 8);
    x.v = *(const u32x4*)(PS + (tokb + 64 * j + (tid >> 3)) * PSLD + VC + h * 64 + (tid & 7) * 8);
    if (!SB) x.bias = -(coff + clrow[64 * j + (tid & 63)]) * 1.4426950408889634f;
}
template <bool SB>
__device__ __forceinline__ void attn_store(LAS unsigned char* lds, int buf, int tid, const TileRegs& x) {
    *(LAS u32x4*)(lds + buf * 9216 + ((tid >> 3) * 72 + (tid & 7) * 8) * 2) = x.k;
    *(LAS u32x4*)(lds + 18432 + buf * 9216 + ((tid >> 3) * 72 + (tid & 7) * 8) * 2) = x.v;
    if (!SB) { if (tid < 64) *(LAS float*)(lds + 36864 + buf * 256 + tid * 4) = x.bias; }
}
template <bool SB>
__device__ __forceinline__ void attn_unit(const Params& P, int b, int h, int qb, LAS unsigned char* lds, int tid) {
    const int lane = tid & 63, r32 = lane & 31, hi = lane >> 5, w = tid >> 6;
    const size_t tokb = (size_t)b * SEQ; const int q0 = qb * 256, qw0 = q0 + 32 * w, qpos = qw0 + r32, jd = qw0 >> 6;
    const bf16_t* PS = WSP(bf16_t, OFF_PS); constexpr int QC = SB ? 2048 : 256, OC = SB ? 768 : 256;
    const float* clrow = WSP(float, OFF_CL) + ((size_t)b * 4 + h) * SEQ;
    bf16x8 qr[4];
#pragma unroll
    for (int d0 = 0; d0 < 4; ++d0) qr[d0] = *(const bf16x8*)(PS + (tokb + qpos) * PSLD + QC + h * 64 + d0 * 16 + hi * 8);
    f32x16 O0, O1;
#pragma unroll
    for (int r = 0; r < 16; ++r) { O0[r] = 0.f; O1[r] = 0.f; }
    float mrun = -INFINITY, lrun = 0.f, Rrun = 0.f, coff = 0.f;
    const int NT = 4 * qb + 4;
    TileRegs x;
    { const int j = SB ? NT - 1 : 0; attn_load<SB>(P, tokb, h, j, tid, coff, clrow, x); attn_store<SB>(lds, 0, tid, x); if (!SB) coff += clrow[64 * j + 63]; }
    __syncthreads();
    for (int it = 0; it < NT; ++it) {
        const int j = SB ? NT - 1 - it : it, buf = it & 1; const bool more = it + 1 < NT;
        if (more) { const int jn = SB ? j - 1 : j + 1; attn_load<SB>(P, tokb, h, jn, tid, coff, clrow, x); if (!SB) coff += clrow[64 * jn + 63]; }
        if (j <= jd) {
            const LAS bf16_t* Ks = (const LAS bf16_t*)(lds + buf * 9216); const LAS bf16_t* Vt = (const LAS bf16_t*)(lds + 18432 + buf * 9216);
            f32x16 p0, p1;
            if (!SB) {
                const LAS float* bs0 = (const LAS float*)(lds + 36864 + buf * 256);
#pragma unroll
                for (int rq = 0; rq < 4; ++rq) { const f32x4 b0 = *(const LAS f32x4*)(bs0 + 8 * rq + 4 * hi), b1 = *(const LAS f32x4*)(bs0 + 32 + 8 * rq + 4 * hi);
#pragma unroll
                    for (int i = 0; i < 4; ++i) { p0[4 * rq + i] = b0[i]; p1[4 * rq + i] = b1[i]; } }
            } else {
#pragma unroll
                for (int r = 0; r < 16; ++r) { p0[r] = 0.f; p1[r] = 0.f; }
            }
            __builtin_amdgcn_s_setprio(1);
#pragma unroll
            for (int d0 = 0; d0 < 4; ++d0) {
                const bf16x8 a0 = *(const LAS bf16x8*)(Ks + r32 * 72 + d0 * 16 + hi * 8), a1 = *(const LAS bf16x8*)(Ks + (32 + r32) * 72 + d0 * 16 + hi * 8);
                p0 = MFMA32(a0, qr[d0], p0); p1 = MFMA32(a1, qr[d0], p1);
            }
            __builtin_amdgcn_s_setprio(0);
            const int kbase = 64 * j + 4 * hi;
            bf16x8 pf[4];
            if (!SB) {
                float mt = -INFINITY;
                if (j == jd) {
#pragma unroll
                    for (int rq = 0; rq < 4; ++rq)
#pragma unroll
                        for (int i = 0; i < 4; ++i) { const int r = 4 * rq + i; const int kp = kbase + i + 8 * rq;
                            if (kp > qpos) p0[r] = -INFINITY; if (kp + 32 > qpos) p1[r] = -INFINITY; }
                }
#pragma unroll
                for (int r = 0; r < 16; ++r) mt = fmaxf(mt, fmaxf(p0[r], p1[r]));
                mt = fmaxf(mt, other_half(mt, hi));
                const float mnew = fmaxf(mrun, mt), alpha = __builtin_amdgcn_exp2f(mrun - mnew); mrun = mnew;
                float ls = 0.f;
#pragma unroll
                for (int r = 0; r < 16; ++r) { p0[r] = __builtin_amdgcn_exp2f(p0[r] - mnew); p1[r] = __builtin_amdgcn_exp2f(p1[r] - mnew); ls += p0[r] + p1[r]; }
                lrun = lrun * alpha + ls;
#pragma unroll
                for (int r = 0; r < 16; ++r) { O0[r] *= alpha; O1[r] *= alpha; }
            } else {
                float gs[2][4], og[2][4]; f32x16 lr0, lr1;
#pragma unroll
                for (int rq = 0; rq < 4; ++rq) { float g0 = 0.f, g1 = 0.f;
#pragma unroll
                    for (int i = 0; i < 4; ++i) { const int r = 4 * rq + i; const int kp = kbase + i + 8 * rq;
                        const float z0 = p0[r], z1 = p1[r];
                        const float sp0 = fmaxf(z0, 0.f) + __builtin_amdgcn_logf(1.f + __builtin_amdgcn_exp2f(-fabsf(z0))), sp1 = fmaxf(z1, 0.f) + __builtin_amdgcn_logf(1.f + __builtin_amdgcn_exp2f(-fabsf(z1)));
                        const bool in0 = kp < qpos, in1 = kp + 32 < qpos;
                        lr0[r] = in0 ? -sp0 : 0.f; lr1[r] = in1 ? -sp1 : 0.f;
                        p0[r] = in0 ? z0 - sp0 : -INFINITY; p1[r] = in1 ? z1 - sp1 : -INFINITY;
                        g0 += lr0[r]; g1 += lr1[r]; }
                    gs[0][rq] = g0; gs[1][rq] = g1; }
#pragma unroll
                for (int kb = 0; kb < 2; ++kb)
#pragma unroll
                    for (int rq = 0; rq < 4; ++rq) og[kb][rq] = other_half(gs[kb][rq], hi);
                float T = 0.f;
#pragma unroll
                for (int kb = 1; kb >= 0; --kb)
#pragma unroll
                    for (int rq = 3; rq >= 0; --rq) {
                        float run = Rrun + T + (hi == 0 ? og[kb][rq] : 0.f);
#pragma unroll
                        for (int i = 3; i >= 0; --i) { const int r = 4 * rq + i;
                            if (kb) { const float wgt = __builtin_amdgcn_exp2f(p1[r] + run); run += lr1[r]; p1[r] = wgt; }
                            else { const float wgt = __builtin_amdgcn_exp2f(p0[r] + run); run += lr0[r]; p0[r] = wgt; } }
                        T += gs[kb][rq] + og[kb][rq];
                    }
                Rrun += T;
            }
#pragma unroll
            for (int ks = 0; ks < 4; ++ks) { u32x4 o;
#pragma unroll
                for (int i = 0; i < 4; ++i) { const int r = 8 * (ks & 1) + 2 * i; o[i] = (ks >> 1) ? pk2(p1[r], p1[r + 1]) : pk2(p0[r], p0[r + 1]); }
                pf[ks] = __builtin_bit_cast(bf16x8, o); }
#pragma unroll
            for (int ks = 0; ks < 4; ++ks) {
                const LAS bf16_t* vb = Vt + (16 * ks + 4 * hi + ((lane & 15) >> 2)) * 72 + 16 * ((lane >> 4) & 1) + 4 * (lane & 3);
                const s16x4 v0a = __builtin_amdgcn_ds_read_tr16_b64_v4i16((LAS s16x4*)(vb)), v0b = __builtin_amdgcn_ds_read_tr16_b64_v4i16((LAS s16x4*)(vb + 8 * 72));
                const s16x4 v1a = __builtin_amdgcn_ds_read_tr16_b64_v4i16((LAS s16x4*)(vb + 32)), v1b = __builtin_amdgcn_ds_read_tr16_b64_v4i16((LAS s16x4*)(vb + 8 * 72 + 32));
                bf16x8 a0, a1;
#pragma unroll
                for (int e = 0; e < 4; ++e) { a0[e] = v0a[e]; a0[4 + e] = v0b[e]; a1[e] = v1a[e]; a1[4 + e] = v1b[e]; }
                __builtin_amdgcn_s_setprio(1); O0 = MFMA32(a0, pf[ks], O0); O1 = MFMA32(a1, pf[ks], O1); __builtin_amdgcn_s_setprio(0);
            }
        }
        if (more) attn_store<SB>(lds, buf ^ 1, tid, x);
        if (SB) {
            const bool wdone = __builtin_amdgcn_ballot_w64((j <= jd) && (Rrun < -160.f)) == ~0ull;
            LAS unsigned* votes = (LAS unsigned*)(lds + 37376) + (it & 1) * 8;
            if (lane == 0) votes[w] = wdone ? 1u : 0u;
            __syncthreads();
            const u32x4 va = *(const LAS u32x4*)votes, vb = *(const LAS u32x4*)(votes + 4);
            if ((va[0] & va[1] & va[2] & va[3] & vb[0] & vb[1] & vb[2] & vb[3]) != 0u) break;
        }
        else __syncthreads();
    }
    if (!SB) { const float lt = lrun + other_half(lrun, hi); const float inv = 1.f / lt;
#pragma unroll
        for (int r = 0; r < 16; ++r) { O0[r] *= inv; O1[r] *= inv; } }
    bf16_t* orow = WSP(bf16_t, OFF_YC) + (tokb + qpos) * 1024 + OC + h * 64 + 4 * hi;
#pragma unroll
    for (int rq = 0; rq < 4; ++rq) {
        u32x2 t0; t0[0] = pk2(O0[4 * rq], O0[4 * rq + 1]); t0[1] = pk2(O0[4 * rq + 2], O0[4 * rq + 3]); *(u32x2*)(orow + 8 * rq) = t0;
        u32x2 t1; t1[0] = pk2(O1[4 * rq], O1[4 * rq + 1]); t1[1] = pk2(O1[4 * rq + 2], O1[4 * rq + 3]); *(u32x2*)(orow + 32 + 8 * rq) = t1;
    }
    __syncthreads();
}

#define XB_TMO      128
#define XB_XCNT(j)  (256  + 64 * (j))
#define XB_XSUB(j)  (1280 + 64 * (j))
#define XB_XGEN(j)  (2304 + 64 * (j))
#define XB_TOP      3328
#define XB_TOPGEN   3392
#define XCD_BAR_WORDS 3456
#define XB_SPIN_CAP (1u << 18)
__device__ __forceinline__ unsigned xb_ld(unsigned* p)              { return __hip_atomic_load(p, __ATOMIC_RELAXED, __HIP_MEMORY_SCOPE_AGENT); }
__device__ __forceinline__ unsigned xb_add(unsigned* p, unsigned v) { return __hip_atomic_fetch_add(p, v, __ATOMIC_RELAXED, __HIP_MEMORY_SCOPE_AGENT); }
__device__ __forceinline__ unsigned xb_xcc_id() { return (unsigned)__builtin_amdgcn_s_getreg((3 << 11) | 20) & 0xFu; }
#define XB_SPIN(cond, bar) do { unsigned _sp = 0; while (cond) { __builtin_amdgcn_s_sleep(1); \
    if ((++_sp & 255u) == 0u) { if (xb_ld(&(bar)[XB_TMO])) break; if (_sp > XB_SPIN_CAP) { atomicAdd(&(bar)[XB_TMO], 1u); break; } } } } while (0)
struct XcdBarrier { unsigned* bar; unsigned x; volatile LAS unsigned* st; };
__device__ __forceinline__ XcdBarrier xcd_barrier_post(unsigned* bar, volatile LAS unsigned* st) {
    XcdBarrier b; b.bar = bar; b.x = xb_xcc_id(); b.st = st;
    if (threadIdx.x == 0) (void)xb_add(&bar[XB_XCNT(b.x)], 1u);
    return b;
}
__device__ __forceinline__ void xcd_barrier_complete(unsigned* bar, unsigned x, unsigned& nloc, unsigned& nx) {
    const unsigned G = gridDim.x * gridDim.y * gridDim.z;
    unsigned sum, cnt, mine, sp = 0u;
    for (;;) {
        sum = 0u; cnt = 0u; mine = 0u;
#pragma unroll
        for (unsigned j = 0; j < 16; ++j) { const unsigned c = xb_ld(&bar[XB_XCNT(j)]); sum += c; cnt += (c > 0u) ? 1u : 0u; mine = (j == x) ? c : mine; }
        if (sum == G) break;
        __builtin_amdgcn_s_sleep(1);
        if ((++sp & 255u) == 0u) { if (xb_ld(&bar[XB_TMO])) break; if (sp > XB_SPIN_CAP) { atomicAdd(&bar[XB_TMO], 1u); break; } }
    }
    nloc = mine > 0u ? mine : 1u; nx = cnt > 0u ? cnt : 1u;
}
__device__ __forceinline__ void xcd_barrier(const XcdBarrier& b) {
    asm volatile("s_waitcnt vmcnt(0)" ::: "memory");
    __syncthreads();
    if (threadIdx.x == 0) {
        unsigned* bar = b.bar;
        __builtin_amdgcn_s_waitcnt(0);
        unsigned nloc = b.st[0], nx = b.st[1];
        if (nloc == 0u) { xcd_barrier_complete(bar, b.x, nloc, nx); b.st[0] = nloc; b.st[1] = nx; }
        const unsigned old = xb_add(&bar[XB_XSUB(b.x)], 1u);
        const unsigned gen = old / nloc;
        if (old + 1u == (gen + 1u) * nloc) {
            __builtin_amdgcn_fence(__ATOMIC_RELEASE, "agent");
            asm volatile("s_waitcnt vmcnt(0)" ::: "memory");
            const unsigned og = xb_add(&bar[XB_TOP], 1u);
            const unsigned tg = og / nx;
            if (og + 1u == (tg + 1u) * nx) xb_add(&bar[XB_TOPGEN], 1u);
            else XB_SPIN(xb_ld(&bar[XB_TOPGEN]) == tg, bar);
            __builtin_amdgcn_fence(__ATOMIC_ACQUIRE, "agent");
            xb_add(&bar[XB_XGEN(b.x)], 1u);
            asm volatile("s_waitcnt vmcnt(0)" ::: "memory");
        } else {
            XB_SPIN(xb_ld(&bar[XB_XGEN(b.x)]) == gen, bar);
            __builtin_amdgcn_fence(__ATOMIC_ACQUIRE, "agent");
            asm volatile("s_waitcnt vmcnt(0)" ::: "memory");
        }
    }
    __syncthreads();
}

#ifndef REP_K
#define REP_K -2
#endif
#ifndef MK_LAUNCHES
#define MK_LAUNCHES 1
#endif
__global__ void __launch_bounds__(512, 2) fwd_megakernel(Params P0, int ph_lo, int ph_hi) {
    extern __shared__ __attribute__((aligned(16))) unsigned char smem[];
    __shared__ int s_task;
    __shared__ unsigned xb_st[2];
    LAS unsigned char* lds = (LAS unsigned char*)smem;
    const int wave0 = __builtin_amdgcn_readfirstlane(threadIdx.x >> 6), G = gridDim.x, c = blockIdx.x, NGW = G * 8;
    __builtin_assume(G >= 1 && G <= 256 && c >= 0 && c < 256);
    if (threadIdx.x == 0) { xb_st[0] = 0u; xb_st[1] = 0u; }
    __syncthreads();
    const XcdBarrier xb = xcd_barrier_post((unsigned*)(P0.ws + OFF_BAR), (volatile LAS unsigned*)xb_st);
#define TID() ({ int t_ = (int)__builtin_amdgcn_mbcnt_hi(~0u, __builtin_amdgcn_mbcnt_lo(~0u, 0u)); asm volatile("" : "+v"(t_)); t_ | (wave0 << 6); })
#define PHASE_IDS() const int tid = TID(), lane = tid & 63, wave = tid >> 6, gw = c * 8 + wave; (void)lane; (void)gw
#pragma unroll 1
    for (int phx = ph_lo * 2; phx < ph_hi * 2; ++phx) {
        const Params& P = P0;
        unsigned* ctr = WSP(unsigned, OFF_CTR);
        const int ph = phx >> 1, rep = phx & 1;
        const int L = ph == 0 ? 0 : (ph - 1) / 10, k = ph == 0 ? -1 : (ph - 1) % 10;
        if (rep == 1 && k != REP_K) continue;
        if (ph == 0) {
            PHASE_IDS();
            if (c == 0 && tid < 64) ctr[tid] = 0u;
            for (int t = c; t < WCONV_TASKS; t += G) wconv_task(P, 0, t, (LAS float*)lds, tid);
            for (int t = c; t < MTOK * 1024 / 4096; t += G) cvt_task(P.in[IX], WSP(bf16_t, OFF_HB), t, tid);
        } else if (k == 0) {
#ifndef NO_G1
            SchedG1 S{P, G, c}; EpiG1 E{P}; pg8::gemm_phase(lds, S, E, TID());
#endif
        } else if (k == 1) {
            PHASE_IDS();
#ifndef NO_PREP
            for (int t = c; t < MTOK / 32; t += G) rwkv_prep(P, L, t, lds, tid);
#endif
#ifndef NO_S51
            for (int t = gw; t < NB * 16 * 16; t += NGW) s5_pass1(P, L, t, lane);
#endif
            for (int t = gw; t < NB * 64; t += NGW) cl_task(P, L, t, lane);
        } else if (k == 2) {
            PHASE_IDS();
            for (;;) {
                if (tid == 0) s_task = (int)atomicAdd(ctr + L * 2 + rep, 1u);
                __syncthreads();
                int t = s_task;
                __syncthreads();
                if (t >= 128 + 512 + 256 + 512) break;
                { const int a_ = t - 128; if (a_ >= 224 && a_ < 224 + 256) t = 128 + 512 + (a_ - 224); else if (a_ >= 224 + 256 && a_ < 512 + 256) t = 128 + 224 + (a_ - 224 - 256); }
#ifdef REP_MASK
                if (rep == 1) { const int cls = t < 128 ? 1 : t < 128 + 512 ? 2 : t < 128 + 512 + 256 ? 4 : 8; if (!(cls & REP_MASK)) continue; }
#endif
#ifndef NO_SCAN
                if (t < 128) rwkv_scan(P, t, lds, tid); else
#endif
#ifndef NO_FOX
                if (t < 128 + 512) { const int i = t - 128; attn_unit<false>(P, (i & 31) >> 2, i & 3, 15 - (i >> 5), lds, tid); } else
#endif
#ifndef NO_S53
                if (t < 128 + 512 + 256) s5_pass3(P, L, t - (128 + 512), lds, tid); else
#endif
#ifndef NO_SB
                { const int i = t - (128 + 512 + 256); attn_unit<true>(P, (i & 31) >> 2, i & 3, 15 - (i >> 5), lds, tid); }
#else
                {}
#endif
            }
        } else if (k == 3) {
            PHASE_IDS(); for (int tok = gw; tok < MTOK; tok += NGW) rwkv_post(P, L, (size_t)tok, lane);
        } else if (k == 4) {
#ifndef NO_G2
            SchedG2 S{P, G, c}; EpiG2 E{P}; pg8::gemm_phase(lds, S, E, TID());
#endif
        } else if (k == 5) {
#ifndef NO_G3
            SchedG3 S{P, G, c}; EpiG3 E{P, L == 0 ? P.in[IX] : (const float*)P.out, L == 0 ? (const float*)nullptr : P.in[ILN2G] + (L - 1) * 1024, L == 0 ? (const float*)nullptr : P.in[ILN2B] + (L - 1) * 1024}; pg8::gemm_phase(lds, S, E, TID());
#endif
        } else if (k == 6) {
            PHASE_IDS();
            for (int r = gw * 4; r < MTOK; r += NGW * 4) ln_rows4(P.out + (size_t)r * 1024, P.in[ILN1G] + L * 1024, P.in[ILN1B] + L * 1024, WSP(bf16_t, OFF_HB) + (size_t)r * 1024, WSP(f32x2, OFF_STAT) + r, false, lane);
            for (int t = c; t < MTOK * 256 / 4096; t += G) cvt_task(P.in[IP] + (size_t)L * MTOK * 256, WSP(bf16_t, OFF_YC), t, tid);
        } else if (k == 7) {
#ifndef NO_G4
            SchedG4 S{P, G, c}; EpiG4 E{P}; pg8::gemm_phase(lds, S, E, TID());
#endif
        } else if (k == 8) {
#ifndef NO_G5
            SchedG5 S{P, G, c}; EpiG5 E{P, P.in[ILN1G] + L * 1024, P.in[ILN1B] + L * 1024}; pg8::gemm_phase(lds, S, E, TID());
#endif
        } else {
            PHASE_IDS();
            for (int r = gw * 4; r < MTOK; r += NGW * 4) ln_rows4(P.out + (size_t)r * 1024, P.in[ILN2G] + L * 1024, P.in[ILN2B] + L * 1024, L + 1 < DEPTH ? WSP(bf16_t, OFF_HB) + (size_t)r * 1024 : (bf16_t*)nullptr, L + 1 < DEPTH ? WSP(f32x2, OFF_STAT) + r : (f32x2*)nullptr, L + 1 == DEPTH, lane);
            if (L + 1 < DEPTH) { for (int t = c; t < WCONV_TASKS; t += G) wconv_task(P, L + 1, t, (LAS float*)lds, tid); }
        }
        if (phx + 1 < ph_hi * 2) { if (ph_lo < 0) cg::this_grid().sync(); else xcd_barrier(xb); }
    }
}
constexpr int N_PHASES = 1 + 10 * DEPTH;

#ifdef PROBE_PH
__global__ void probe_dump(Params P, int mode) {
    const size_t i = (size_t)blockIdx.x * blockDim.x + threadIdx.x; if (i >= (size_t)MTOK * 1024) return;
    const size_t tok = i >> 10; const int c = (int)(i & 1023);
    float v = 0.f;
    if (mode == 0) { v = bf1(WSP(bf16_t, OFF_PS)[tok * PSLD + c]); }
    else if (mode == 1) { v = bf1(WSP(bf16_t, OFF_PS)[tok * PSLD + 1024 + 768 + c]); if (c >= 1024 - 0) v = 0.f; }
    else if (mode == 2) { v = (c >= 512 && c < 768) ? 0.f : bf1(WSP(bf16_t, OFF_YC)[tok * 1024 + c]); }
    else if (mode == 3) { v = bf1(WSP(bf16_t, OFF_YC)[tok * 1024 + c]); }
    else if (mode == 4) { v = bf1(WSP(bf16_t, OFF_MG)[tok * 1024 + c]); }
    else if (mode == 5) { v = c < 256 ? WSP(float, OFF_RW_DEC)[tok * 256 + c] : c < 512 ? bf1(WSP(bf16_t, OFF_RW_KK)[tok * 256 + c - 256]) : c < 768 ? bf1(WSP(bf16_t, OFF_RW_B)[tok * 256 + c - 512]) : bf1(WSP(bf16_t, OFF_RW_G)[tok * 256 + c - 768]); }
    else if (mode == 6) { v = c < 256 ? ((const float*)(P.ws + OFF_PS + 2048 + tok * (PSLD * 2)))[c] : 0.f; }
    else if (mode == 7) { v = P.out[i]; }
    else if (mode == 10) { v = c < 256 ? bf1(WSP(bf16_t, OFF_RW_KK)[tok * 256 + c]) : c < 512 ? bf1(WSP(bf16_t, OFF_RW_V)[tok * 256 + c - 256]) : c < 768 ? bf1(WSP(bf16_t, OFF_RW_R)[tok * 256 + c - 512]) : 0.f; }
    else if (mode == 12) { v = c < 768 ? bf1(WSP(bf16_t, OFF_YC)[tok * 1024 + c]) : bf1(WTP(WT_RW2)[(i >> 2) & 65535]); }
    else if (mode == 13) { v = c < 256 ? WSP(float, OFF_RW_DEC)[tok * 256 + c] : 0.f; }
    else if (mode == 14) { v = c < 256 ? bf1(WSP(bf16_t, OFF_RW_B)[tok * 256 + c]) : c < 512 ? bf1(WSP(bf16_t, OFF_RW_G)[tok * 256 + c - 256]) : c < 768 ? bf1(WSP(bf16_t, OFF_RW_K)[tok * 256 + c - 512]) : 0.f; }
    else if (mode == 8) { v = bf1(WSP(bf16_t, OFF_PS)[tok * PSLD + 1024 + c]); }
    else if (mode == 9) { v = c < 256 ? bf1(WSP(bf16_t, OFF_RW_R)[tok * 256 + c]) : c < 512 ? bf1(WSP(bf16_t, OFF_RW_K)[tok * 256 + c - 256]) : c < 768 ? bf1(WSP(bf16_t, OFF_RW_V)[tok * 256 + c - 512]) : WSP(float, OFF_RW_DEC)[tok * 256 + c - 768]; }
    P.out[i] = v;
}
#endif
extern "C" void kernel_launch(void* const* d_in, const int* in_sizes, int n_in, void* d_out, int out_size, void* d_ws, size_t ws_size, hipStream_t stream) {
    static int grid = 0;
    if (grid == 0) {
        if (n_in != NIN || out_size != MTOK * 1024 || ws_size < WS_END) { fprintf(stderr, "kernel_launch: unexpected shapes: n_in %d out %d ws %zu (need %zu)\n", n_in, out_size, ws_size, (size_t)WS_END); grid = -1; return; }
        int dev = 0, cus = 0, per_cu = 0;
        (void)hipGetDevice(&dev); (void)hipDeviceGetAttribute(&cus, hipDeviceAttributeMultiprocessorCount, dev);
        if (hipFuncSetAttribute((const void*)fwd_megakernel, hipFuncAttributeMaxDynamicSharedMemorySize, LDS_BYTES) != hipSuccess) { fprintf(stderr, "kernel_launch: hipFuncSetAttribute failed\n"); grid = -1; return; }
        if (hipOccupancyMaxActiveBlocksPerMultiprocessor(&per_cu, (const void*)fwd_megakernel, 512, LDS_BYTES) != hipSuccess || per_cu < 1) { fprintf(stderr, "kernel_launch: occupancy query says %d\n", per_cu); per_cu = 1; }
        (void)hipGetLastError();
        grid = cus * per_cu; if (grid > 256) grid = 256;
        if (grid < 1) grid = -1;
    }
    if (grid < 0) return;
    if (hipMemsetAsync((char*)d_ws + OFF_CTR, 0, 4096 + 16384, stream) != hipSuccess) { fprintf(stderr, "kernel_launch: memset of control words failed\n"); return; }
    Params p{};
    for (int i = 0; i < NIN; ++i) p.in[i] = (const float*)d_in[i];
    p.out = (float*)d_out; p.ws = (unsigned char*)d_ws;
#if MK_LAUNCHES == 1
    int lo = 0, hi = N_PHASES;
    void* args[] = {&p, &lo, &hi};
    hipError_t e = hipLaunchCooperativeKernel((const void*)fwd_megakernel, dim3(grid), dim3(512), args, LDS_BYTES, stream);
    if (e != hipSuccess) fprintf(stderr, "cooperative launch failed: %s (grid %d)\n", hipGetErrorString(e), grid);
#else
#ifdef PROBE_PH
    for (int ph = 0; ph < PROBE_PH; ++ph) hipLaunchKernelGGL(fwd_megakernel, dim3(grid), dim3(512), LDS_BYTES, stream, p, ph, ph + 1);
    hipLaunchKernelGGL(probe_dump, dim3(MTOK * 1024 / 256), dim3(256), 0, stream, p, PROBE_MODE);
#else
    for (int ph = 0; ph < N_PHASES; ++ph) hipLaunchKernelGGL(fwd_megakernel, dim3(grid), dim3(512), LDS_BYTES, stream, p, ph, ph + 1);
#endif
#endif
}
```

```cpp
#include <hip/hip_runtime.h>
#include <hip/hip_cooperative_groups.h>
#include <cstdio>
#include <cstdint>
namespace cg = cooperative_groups;

#define LAS __attribute__((address_space(3)))
typedef unsigned short bf16_t;
typedef short bf16x8 __attribute__((ext_vector_type(8)));
typedef short s16x4 __attribute__((ext_vector_type(4)));
typedef float f32x4 __attribute__((ext_vector_type(4)));
typedef float f32x2 __attribute__((ext_vector_type(2)));
typedef float f32x16 __attribute__((ext_vector_type(16)));
typedef unsigned u32x4 __attribute__((ext_vector_type(4)));
typedef unsigned u32x2 __attribute__((ext_vector_type(2)));

constexpr int DM = 1024, NB = 8, SEQ = 4096, MTOK = NB * SEQ, DEPTH = 2, PLE = 256, BW = 256, DFF = 4096, DIN = 6916;
constexpr int PSLD = 2816;
constexpr float LN_EPS = 1e-5f, GN_EPS = 64e-5f;
constexpr float ALPHA = 1.4142135623730951f;
enum { IX = 0, IP, IW_IN, IS5_LRE, IS5_LIM, IS5_LDT, IS5_BRE, IS5_BIM, IS5_CRE, IS5_CIM, IS5_D, IS5_GLUW, IS5_GLUB, IFOX_B, IRW_MU, IRW_W0, IRW_W2, IRW_A0, IRW_A2,
       IRW_G2, IRW_KK, IRW_KA, IRW_RK, IRW_LNG, IRW_LNB, IW_BR, IW_OUT, ILN1G, ILN1B, IW1, IW2, IPLE_W, IPLE_G, ILN2G, ILN2B, NIN };

constexpr size_t SZ_M1024_BF = (size_t)MTOK * 1024 * 2;
constexpr size_t OFF_YC = 0;
constexpr size_t OFF_PS = OFF_YC + SZ_M1024_BF;
constexpr size_t SZ_PS = (size_t)MTOK * PSLD * 2;
constexpr size_t OFF_RW = OFF_PS + SZ_PS;
constexpr size_t SZ_M256_BF = (size_t)MTOK * 256 * 2;
constexpr size_t OFF_RW_DEC = OFF_RW;
constexpr size_t OFF_RW_R = OFF_RW_DEC + 2 * SZ_M256_BF;
constexpr size_t OFF_RW_K = OFF_RW_R + SZ_M256_BF;
constexpr size_t OFF_RW_V = OFF_RW_K + SZ_M256_BF;
constexpr size_t OFF_RW_KK = OFF_RW_V + SZ_M256_BF;
constexpr size_t OFF_RW_B = OFF_RW_KK + SZ_M256_BF;
constexpr size_t OFF_RW_G = OFF_RW_B + SZ_M256_BF;
constexpr size_t OFF_RW_END = OFF_RW_G + SZ_M256_BF;
constexpr size_t OFF_U = OFF_PS;
constexpr size_t OFF_G5S = OFF_U + (size_t)MTOK * 4096 * 2;
constexpr size_t OFF_G2S = OFF_PS;
constexpr size_t OFF_MG = OFF_RW;
constexpr size_t OFF_HB = OFF_RW_END;
constexpr size_t OFF_WT = OFF_HB + SZ_M1024_BF;
constexpr size_t WT_IN = 0;
constexpr size_t WT_BR = WT_IN + (size_t)DIN * 1024;
constexpr size_t WT_OUT = WT_BR + 4 * 1024 * 256;
constexpr size_t WT_W1 = WT_OUT + 1024 * 1024;
constexpr size_t WT_W2 = WT_W1 + 4096 * 1024;
constexpr size_t WT_PL = WT_W2 + 4096 * 1024;
constexpr size_t WT_PG = WT_PL + 1024 * 256;
constexpr size_t WT_GLU = WT_PG + 1024 * 1024;
constexpr size_t WT_RW2 = WT_GLU + 256 * 256;
constexpr size_t WT_RA2 = WT_RW2 + 256 * 64;
constexpr size_t WT_RG2 = WT_RA2 + 256 * 64;
constexpr size_t WT_END = WT_RG2 + 256 * 128;
constexpr size_t OFF_FL = OFF_WT + WT_END * 2;
constexpr size_t OFF_CL = OFF_FL + (size_t)MTOK * 4 * 4;
constexpr size_t OFF_E256 = OFF_CL + (size_t)MTOK * 4 * 4;
constexpr size_t OFF_L32 = OFF_E256 + (size_t)NB * 16 * 16 * 64 * 8;
constexpr size_t OFF_CTR = OFF_L32 + (size_t)NB * 128 * 16 * 64 * 8;
constexpr size_t OFF_BAR = OFF_CTR + 4096;
constexpr size_t OFF_STAT = OFF_BAR + 16384;
constexpr size_t WS_END = OFF_STAT + (size_t)MTOK * 8;
static_assert(OFF_G5S + (size_t)256 * 131072 <= OFF_RW_END, "G5 scratch must fit in the dead rwkv region");
static_assert(WS_END <= (size_t)536870912, "workspace map exceeds 512 MiB");

constexpr int LDS_BYTES = 131072 + 16384;

typedef __bf16 bf16x2_t __attribute__((ext_vector_type(2)));
__device__ __forceinline__ unsigned pk2(float lo, float hi) { f32x2 v; v[0] = lo; v[1] = hi; bf16x2_t r = __builtin_convertvector(v, bf16x2_t); return __builtin_bit_cast(unsigned, r); }
__device__ __forceinline__ float bflo(unsigned u) { return __uint_as_float(u << 16); }
__device__ __forceinline__ float bfhi(unsigned u) { return __uint_as_float(u & 0xffff0000u); }
__device__ __forceinline__ float bf1(bf16_t u) { return __uint_as_float(((unsigned)u) << 16); }
__device__ __forceinline__ float sigm(float x) { return __builtin_amdgcn_rcpf(1.f + __expf(-x)); }
__device__ __forceinline__ float lane_get(float v, int src_lane) { return __builtin_bit_cast(float, __builtin_amdgcn_ds_bpermute(src_lane << 2, __builtin_bit_cast(int, v))); }
__device__ __forceinline__ float wave_sum(float v, int lane) {
#pragma unroll
    for (int o = 1; o < 64; o <<= 1) v += lane_get(v, lane ^ o);
    return v;
}
__device__ __forceinline__ float rowsum16(float x) {
    x += __builtin_bit_cast(float, __builtin_amdgcn_update_dpp(0, __builtin_bit_cast(int, x), 0x128, 0xf, 0xf, false));
    x += __builtin_bit_cast(float, __builtin_amdgcn_update_dpp(0, __builtin_bit_cast(int, x), 0x124, 0xf, 0xf, false));
    x += __builtin_bit_cast(float, __builtin_amdgcn_update_dpp(0, __builtin_bit_cast(int, x), 0x122, 0xf, 0xf, false));
    x += __builtin_bit_cast(float, __builtin_amdgcn_update_dpp(0, __builtin_bit_cast(int, x), 0x121, 0xf, 0xf, false));
    return x;
}
__device__ __forceinline__ void rowsum16x2(float& a, float& b) {
#define DPP_ROR_(x, c) __builtin_bit_cast(float, __builtin_amdgcn_update_dpp(0, __builtin_bit_cast(int, x), c, 0xf, 0xf, false))
    float ta = DPP_ROR_(a, 0x128), tb = DPP_ROR_(b, 0x128); a += ta; b += tb;
    ta = DPP_ROR_(a, 0x124); tb = DPP_ROR_(b, 0x124); a += ta; b += tb;
    ta = DPP_ROR_(a, 0x122); tb = DPP_ROR_(b, 0x122); a += ta; b += tb;
    ta = DPP_ROR_(a, 0x121); tb = DPP_ROR_(b, 0x121); a += ta; b += tb;
#undef DPP_ROR_
}
__device__ __forceinline__ float other_half(float v, int hi) {
    auto rr = __builtin_amdgcn_permlane32_swap(__float_as_uint(v), __float_as_uint(v), false, false);
    return __uint_as_float(hi ? rr[0] : rr[1]);
}

namespace pg8 {
constexpr int BM = 256, BK = 64, HALF = 128, HTB = HALF * BK * 2, STAGE_BYTES = 8 * HTB, NXCD = 8, WGM = 8;
__device__ __forceinline__ int lds_byte(int r, int c) { const int st = (r >> 4) * 2 + (c >> 5), rr = r & 15, cc = c & 31, ob = rr * 64 + cc * 2; return st * 1024 + (ob ^ (((ob >> 9) & 1) << 5)); }
__device__ __forceinline__ void stage_rc(int b, int& R, int& C) { const int st = b / 1024, sb = b % 1024, swz = sb ^ (((sb >> 9) & 1) << 5); R = (st >> 1) * 16 + swz / 64; C = (st & 1) * 32 + (swz % 64) / 2; }
__device__ __forceinline__ int perm32(int rho) { const int n = rho >> 4, i = rho & 15; return 8 * (i >> 2) + 4 * n + (i & 3); }

struct GUnit { const char* A; const char* B; unsigned lda, ldb; int nt, pm, pn, kind; };

__device__ __forceinline__ void tile_of(int L, int nM, int nN, int& pm, int& pn) {
    const int nwg = nM * nN; int wgid = L;
    { const int q = nwg / NXCD, r = nwg % NXCD, xcd = wgid % NXCD, off = wgid / NXCD; wgid = (xcd < r ? xcd * (q + 1) : r * (q + 1) + (xcd - r) * q) + off; }
    const int nig = WGM * nN, gid = wgid / nig, fm = gid * WGM, gsz = (nM - fm) < WGM ? (nM - fm) : WGM;
    pm = fm + ((wgid % nig) % gsz); pn = (wgid % nig) / gsz;
}

template <class Sched, class Epi>
__device__ __forceinline__ void gemm_phase(LAS unsigned char* lds, const Sched& S, const Epi& E, const int tid) {
    const int wid = __builtin_amdgcn_readfirstlane(tid >> 6), lane = tid & 63, wr = wid >> 2, wc = wid & 3, fr = lane & 15, fq = lane >> 4;
    int sR0, sC0, sR1, sC1; stage_rc(tid * 16, sR0, sC0); stage_rc(tid * 16 + 8192, sR1, sC1);
    const int sRb0 = (sR0 & ~31) + perm32(sR0 & 31), sRb1 = (sR1 & ~31) + perm32(sR1 & 31);
    sC0 *= 2; sC1 *= 2;
    const unsigned ldsw = (unsigned)wid * 1024u;
    const int aoff = lds_byte(wr * 64 + fr, fq * 8), boff = lds_byte(wc * 32 + fr, fq * 8);
#define PG8_SA(b, h) (((b) * 2 + (h)) * HTB)
#define PG8_SB(b, h) ((4 + (b) * 2 + (h)) * HTB)
#define PG8_STAGE_A(bufoff, gbase, ld) do { \
        __builtin_amdgcn_global_load_lds((const unsigned*)((const char*)(gbase) + (unsigned)(sR0 * (ld) + sC0)), (LAS unsigned*)(lds + (bufoff) + ldsw), 16, 0, 0); \
        __builtin_amdgcn_global_load_lds((const unsigned*)((const char*)(gbase) + (unsigned)(sR1 * (ld) + sC1)), (LAS unsigned*)(lds + (bufoff) + ldsw + 8192), 16, 0, 0); } while (0)
#define PG8_STAGE_B(bufoff, gbase, ld) do { \
        __builtin_amdgcn_global_load_lds((const unsigned*)((const char*)(gbase) + (unsigned)(sRb0 * (ld) + sC0)), (LAS unsigned*)(lds + (bufoff) + ldsw), 16, 0, 0); \
        __builtin_amdgcn_global_load_lds((const unsigned*)((const char*)(gbase) + (unsigned)(sRb1 * (ld) + sC1)), (LAS unsigned*)(lds + (bufoff) + ldsw + 8192), 16, 0, 0); } while (0)
#define PG8_LDA(dst, b, h) do { _Pragma("unroll") for (int m = 0; m < 4; ++m) _Pragma("unroll") for (int k = 0; k < 2; ++k) dst[m][k] = *(const LAS bf16x8*)(lds + PG8_SA(b, h) + aoff + m * 2048 + k * 1024); } while (0)
#define PG8_LDB(dst, b, h) do { _Pragma("unroll") for (int n = 0; n < 2; ++n) _Pragma("unroll") for (int k = 0; k < 2; ++k) dst[n][k] = *(const LAS bf16x8*)(lds + PG8_SB(b, h) + boff + n * 2048 + k * 1024); } while (0)
#define PG8_MMA(ai, bj, At, Bt) do { __builtin_amdgcn_s_setprio(1); _Pragma("unroll") for (int m = 0; m < 4; ++m) _Pragma("unroll") for (int n = 0; n < 2; ++n) _Pragma("unroll") for (int k = 0; k < 2; ++k) \
        acc[ai][bj][m][n] = __builtin_amdgcn_mfma_f32_16x16x32_bf16(Bt[n][k], At[m][k], acc[ai][bj][m][n], 0, 0, 0); __builtin_amdgcn_s_setprio(0); } while (0)
#define PG8_WAIT_V(n) asm volatile("s_waitcnt vmcnt(" #n ")" ::: "memory")
#define PG8_WAIT_L(n) asm volatile("s_waitcnt lgkmcnt(" #n ")" ::: "memory")
#define PG8_BAR __builtin_amdgcn_s_barrier()
#define PG8_SCHED __builtin_amdgcn_sched_barrier(0)
    GUnit cur, nxt; int ui = 0;
    if (!S.next(0, cur)) return;
    f32x4 acc[2][2][4][2];
#pragma unroll
    for (int a = 0; a < 2; ++a)
#pragma unroll
        for (int b = 0; b < 2; ++b)
#pragma unroll
            for (int m = 0; m < 4; ++m)
#pragma unroll
                for (int n = 0; n < 2; ++n) acc[a][b][m][n] = (f32x4){0.f, 0.f, 0.f, 0.f};
    bf16x8 At[4][2], B0[2][2], B1[2][2];
    const char* cA = cur.A; const char* cB = cur.B; unsigned clda = cur.lda, cldb = cur.ldb;
    PG8_STAGE_B(PG8_SB(0, 0), cB, cldb); PG8_STAGE_A(PG8_SA(0, 0), cA, clda); PG8_STAGE_B(PG8_SB(0, 1), cB + (size_t)HALF * cldb, cldb); PG8_STAGE_A(PG8_SA(0, 1), cA + (size_t)HALF * clda, clda);
    if (wr == 1) PG8_BAR;
    PG8_WAIT_V(4); PG8_BAR;
    PG8_STAGE_B(PG8_SB(1, 0), cB + 128, cldb); PG8_STAGE_A(PG8_SA(1, 0), cA + 128, clda); PG8_STAGE_B(PG8_SB(1, 1), cB + (size_t)HALF * cldb + 128, cldb);
    PG8_WAIT_V(6); PG8_BAR;
    for (;;) {
        const bool has_next = S.next(ui + 1, nxt);
        const char* nA = has_next ? nxt.A : cA; const char* nB = has_next ? nxt.B : cB;
        const unsigned nlda = has_next ? nxt.lda : clda, nldb = has_next ? nxt.ldb : cldb;
        const int nt = cur.nt;
        for (int t = 0; t < nt; t += 2) {
            const bool last = (t == nt - 2);
            const char* a1 = cA + (size_t)(t + 1) * 128;
            const char* a2 = last ? nA : cA + (size_t)(t + 2) * 128; const char* b2 = last ? nB : cB + (size_t)(t + 2) * 128;
            const char* a3 = a2 + 128; const char* b3 = b2 + 128;
            const unsigned lda2 = last ? nlda : clda, ldb2 = last ? nldb : cldb;
            PG8_LDB(B0, 0, 0); PG8_SCHED; PG8_LDA(At, 0, 0); PG8_STAGE_A(PG8_SA(1, 1), a1 + (size_t)HALF * clda, clda);
            PG8_WAIT_L(8); PG8_BAR; PG8_WAIT_L(0); PG8_MMA(0, 0, At, B0); PG8_BAR; PG8_SCHED;
            PG8_LDB(B1, 0, 1); PG8_STAGE_B(PG8_SB(0, 0), b2, ldb2);
            PG8_BAR; PG8_WAIT_L(0); PG8_MMA(0, 1, At, B1); PG8_BAR;
            PG8_LDA(At, 0, 1); PG8_STAGE_A(PG8_SA(0, 0), a2, lda2);
            PG8_BAR; PG8_WAIT_L(0); PG8_MMA(1, 0, At, B0); PG8_BAR; PG8_SCHED;
            PG8_STAGE_B(PG8_SB(0, 1), b2 + (size_t)HALF * ldb2, ldb2);
            PG8_WAIT_V(6); PG8_BAR; PG8_MMA(1, 1, At, B1); PG8_BAR;
            PG8_LDB(B0, 1, 0); PG8_SCHED; PG8_LDA(At, 1, 0); PG8_STAGE_A(PG8_SA(0, 1), a2 + (size_t)HALF * lda2, lda2);
            PG8_WAIT_L(8); PG8_BAR; PG8_WAIT_L(0); PG8_MMA(0, 0, At, B0); PG8_BAR; PG8_SCHED;
            PG8_LDB(B1, 1, 1); PG8_STAGE_B(PG8_SB(1, 0), b3, ldb2);
            PG8_BAR; PG8_WAIT_L(0); PG8_MMA(0, 1, At, B1); PG8_BAR;
            PG8_LDA(At, 1, 1); PG8_STAGE_A(PG8_SA(1, 0), a3, lda2);
            PG8_BAR; PG8_WAIT_L(0); PG8_MMA(1, 0, At, B0); PG8_BAR; PG8_SCHED;
            PG8_STAGE_B(PG8_SB(1, 1), b3 + (size_t)HALF * ldb2, ldb2);
            PG8_WAIT_V(6); PG8_BAR; PG8_MMA(1, 1, At, B1); PG8_BAR;
        }
        { int fr2 = fr, fq2 = fq, wr2 = wr, wc2 = wc; asm volatile("" : "+v"(fr2), "+v"(fq2), "+s"(wr2), "+s"(wc2)); E(acc, cur, wr2, wc2, fr2, fq2); }
        if (!has_next) break;
#pragma unroll
        for (int a = 0; a < 2; ++a)
#pragma unroll
            for (int b = 0; b < 2; ++b)
#pragma unroll
                for (int m = 0; m < 4; ++m)
#pragma unroll
                    for (int n = 0; n < 2; ++n) acc[a][b][m][n] = (f32x4){0.f, 0.f, 0.f, 0.f};
        cur = nxt; cA = nA; cB = nB; clda = nlda; cldb = nldb; ++ui;
    }
    PG8_WAIT_V(0);
    if (wr == 0) PG8_BAR;
    PG8_BAR;
#undef PG8_SA
#undef PG8_SB
#undef PG8_STAGE_A
#undef PG8_STAGE_B
#undef PG8_LDA
#undef PG8_LDB
#undef PG8_MMA
#undef PG8_WAIT_V
#undef PG8_WAIT_L
#undef PG8_BAR
#undef PG8_SCHED
}
}
using pg8::GUnit;

struct Params { const float* in[NIN]; float* out; unsigned char* ws; };


#define WSP(T, off) ((T*)(P.ws + (off)))
#define WTP(eoff) ((const bf16_t*)(P.ws + OFF_WT) + (eoff))

__device__ __forceinline__ void tr_tile(const float* __restrict__ src, int ld, int k0, int c0, bf16_t* __restrict__ dst, int K, int r0, LAS float* scr, int tid) {
#pragma unroll
    for (int ps = 0; ps < 2; ++ps) {
        const int i = (tid >> 4) + 32 * ps, j4 = (tid & 15) * 4;
        const f32x4 v = *(const f32x4*)(src + (size_t)(k0 + i) * ld + c0 + j4);
        scr[i * 65 + j4 + 0] = v[0]; scr[i * 65 + j4 + 1] = v[1]; scr[i * 65 + j4 + 2] = v[2]; scr[i * 65 + j4 + 3] = v[3];
    }
    __syncthreads();
    { const int j = tid >> 3, i8 = (tid & 7) * 8;
      u32x4 o; o[0] = pk2(scr[(i8 + 0) * 65 + j], scr[(i8 + 1) * 65 + j]); o[1] = pk2(scr[(i8 + 2) * 65 + j], scr[(i8 + 3) * 65 + j]);
      o[2] = pk2(scr[(i8 + 4) * 65 + j], scr[(i8 + 5) * 65 + j]); o[3] = pk2(scr[(i8 + 6) * 65 + j], scr[(i8 + 7) * 65 + j]);
      *(u32x4*)(dst + (size_t)(r0 + j) * K + k0 + i8) = o; }
    __syncthreads();
}
__device__ __forceinline__ void tr_job(const float* src, int ld, int c0, int K, bf16_t* dst, int t, LAS float* scr, int tid) {
    const int nk = K >> 6, kt = t % nk, rt = t / nk;
    tr_tile(src, ld, kt * 64, c0 + rt * 64, dst, K, rt * 64, scr, tid);
}
constexpr int WC_T0 = 16 * 16, WC_T1 = 16 * 28, WC_T2 = 16 * 64, WC_TBR = 4 * 16, WC_TO = 16 * 16, WC_T1M = 16 * 64, WC_T2M = 64 * 16, WC_TPL = 4 * 16, WC_TPG = 16 * 16,
              WC_TGLU = 4 * 4, WC_TRW = 1 * 4, WC_TRG = 2 * 4;
constexpr int WCONV_TASKS = WC_T0 + WC_T1 + WC_T2 + 4 * WC_TBR + WC_TO + WC_T1M + WC_T2M + WC_TPL + WC_TPG + WC_TGLU + 2 * WC_TRW + WC_TRG + 1;
__device__ __forceinline__ void wconv_task(const Params& P, int L, int t, LAS float* scr, int tid) {
    bf16_t* WT = (bf16_t*)(P.ws + OFF_WT);
    const float* w_in = P.in[IW_IN] + (size_t)L * 1024 * DIN;
    if (t < WC_T0) { tr_job(w_in, DIN, 0, 1024, WT + WT_IN, t, scr, tid); return; } t -= WC_T0;
    if (t < WC_T1) { tr_job(w_in, DIN, 1028, 1024, WT + WT_IN + (size_t)1024 * 1024, t, scr, tid); return; } t -= WC_T1;
    if (t < WC_T2) { tr_job(w_in, DIN, 2820, 1024, WT + WT_IN + (size_t)2820 * 1024, t, scr, tid); return; } t -= WC_T2;
    if (t < 4 * WC_TBR) { const int n = t / WC_TBR; tr_job(P.in[IW_BR] + ((size_t)L * 4 + n) * 256 * 1024, 1024, 0, 256, WT + WT_BR + (size_t)n * 1024 * 256, t % WC_TBR, scr, tid); return; } t -= 4 * WC_TBR;
    if (t < WC_TO) { tr_job(P.in[IW_OUT] + (size_t)L * 1024 * 1024, 1024, 0, 1024, WT + WT_OUT, t, scr, tid); return; } t -= WC_TO;
    if (t < WC_T1M) { tr_job(P.in[IW1] + (size_t)L * 1024 * 4096, 4096, 0, 1024, WT + WT_W1, t, scr, tid); return; } t -= WC_T1M;
    if (t < WC_T2M) { tr_job(P.in[IW2] + (size_t)L * 4096 * 1024, 1024, 0, 4096, WT + WT_W2, t, scr, tid); return; } t -= WC_T2M;
    if (t < WC_TPL) { tr_job(P.in[IPLE_W] + (size_t)L * 256 * 1024, 1024, 0, 256, WT + WT_PL, t, scr, tid); return; } t -= WC_TPL;
    if (t < WC_TPG) { tr_job(P.in[IPLE_G] + (size_t)L * 1024 * 1024, 1024, 0, 1024, WT + WT_PG, t, scr, tid); return; } t -= WC_TPG;
    if (t < WC_TGLU) { tr_job(P.in[IS5_GLUW] + (size_t)L * 256 * 256, 256, 0, 256, WT + WT_GLU, t, scr, tid); return; } t -= WC_TGLU;
    if (t < WC_TRW) { tr_job(P.in[IRW_W2] + (size_t)L * 64 * 256, 256, 0, 64, WT + WT_RW2, t, scr, tid); return; } t -= WC_TRW;
    if (t < WC_TRW) { tr_job(P.in[IRW_A2] + (size_t)L * 64 * 256, 256, 0, 64, WT + WT_RA2, t, scr, tid); return; } t -= WC_TRW;
    if (t < WC_TRG) { tr_job(P.in[IRW_G2] + (size_t)L * 128 * 256, 256, 0, 128, WT + WT_RG2, t, scr, tid); return; } t -= WC_TRG;
    for (int e = tid; e < 4096; e += 512) { const int j = e >> 10, k = e & 1023; WT[WT_IN + (size_t)(2816 + j) * 1024 + k] = (bf16_t)(pk2(w_in[(size_t)k * DIN + 1024 + j], 0.f) & 0xffffu); }
}
__device__ __forceinline__ void cvt_task4(const float* __restrict__ src, bf16_t* __restrict__ dst, int t4, int tid) {
    f32x4 a[4], b[4];
#pragma unroll
    for (int k = 0; k < 4; ++k) { const size_t e = ((size_t)t4 * 4 + k) * 4096 + tid * 8; a[k] = *(const f32x4*)(src + e); b[k] = *(const f32x4*)(src + e + 4); }
#pragma unroll
    for (int k = 0; k < 4; ++k) { const size_t e = ((size_t)t4 * 4 + k) * 4096 + tid * 8;
        u32x4 o; o[0] = pk2(a[k][0], a[k][1]); o[1] = pk2(a[k][2], a[k][3]); o[2] = pk2(b[k][0], b[k][1]); o[3] = pk2(b[k][2], b[k][3]);
        *(u32x4*)(dst + e) = o; }
}
__device__ __forceinline__ void cvt_task(const float* __restrict__ src, bf16_t* __restrict__ dst, int t, int tid) {
    const size_t e = (size_t)t * 4096 + tid * 8;
    const f32x4 a = *(const f32x4*)(src + e), b = *(const f32x4*)(src + e + 4);
    u32x4 o; o[0] = pk2(a[0], a[1]); o[1] = pk2(a[2], a[3]); o[2] = pk2(b[0], b[1]); o[3] = pk2(b[2], b[3]);
    *(u32x4*)(dst + e) = o;
}

__device__ __forceinline__ void ln_row(float* zrow, const float* __restrict__ g, const float* __restrict__ b, bf16_t* hbrow, f32x2* stat, bool wr32, int lane) {
    f32x4 v[4]; float s = 0.f;
#pragma unroll
    for (int j = 0; j < 4; ++j) { v[j] = *(const f32x4*)(zrow + 4 * lane + 256 * j); s += (v[j][0] + v[j][1]) + (v[j][2] + v[j][3]); }
    const float mean = wave_sum(s, lane) * (1.f / 1024.f); float s2 = 0.f;
#pragma unroll
    for (int j = 0; j < 4; ++j) { v[j] = v[j] - mean; s2 += (v[j][0] * v[j][0] + v[j][1] * v[j][1]) + (v[j][2] * v[j][2] + v[j][3] * v[j][3]); }
    const float rstd = rsqrtf(wave_sum(s2, lane) * (1.f / 1024.f) + LN_EPS);
    if (stat && lane == 0) { f32x2 st; st[0] = mean; st[1] = rstd; *stat = st; }
#pragma unroll
    for (int j = 0; j < 4; ++j) {
        const f32x4 gg = *(const f32x4*)(g + 4 * lane + 256 * j), bb = *(const f32x4*)(b + 4 * lane + 256 * j);
        const f32x4 o = v[j] * rstd * gg + bb;
        if (wr32) *(f32x4*)(zrow + 4 * lane + 256 * j) = o;
        if (hbrow) { u32x2 q; q[0] = pk2(o[0], o[1]); q[1] = pk2(o[2], o[3]); *(u32x2*)(hbrow + 4 * lane + 256 * j) = q; }
    }
}

__device__ __forceinline__ void ln_rows4(float* z, const float* __restrict__ g, const float* __restrict__ b, bf16_t* hb, f32x2* stat, bool wr32, int lane) {
    f32x4 v[4][4]; float s[4];
#pragma unroll
    for (int k = 0; k < 4; ++k)
#pragma unroll
        for (int j = 0; j < 4; ++j) v[k][j] = *(const f32x4*)(z + k * 1024 + 4 * lane + 256 * j);
#pragma unroll
    for (int k = 0; k < 4; ++k) { s[k] = 0.f;
#pragma unroll
        for (int j = 0; j < 4; ++j) s[k] += (v[k][j][0] + v[k][j][1]) + (v[k][j][2] + v[k][j][3]); }
#pragma unroll
    for (int o = 1; o < 64; o <<= 1) { float t[4];
#pragma unroll
        for (int k = 0; k < 4; ++k) t[k] = lane_get(s[k], lane ^ o);
#pragma unroll
        for (int k = 0; k < 4; ++k) s[k] += t[k]; }
    float mean[4], s2[4];
#pragma unroll
    for (int k = 0; k < 4; ++k) { mean[k] = s[k] * (1.f / 1024.f); s2[k] = 0.f;
#pragma unroll
        for (int j = 0; j < 4; ++j) { v[k][j] = v[k][j] - mean[k]; s2[k] += (v[k][j][0] * v[k][j][0] + v[k][j][1] * v[k][j][1]) + (v[k][j][2] * v[k][j][2] + v[k][j][3] * v[k][j][3]); } }
#pragma unroll
    for (int o = 1; o < 64; o <<= 1) { float t[4];
#pragma unroll
        for (int k = 0; k < 4; ++k) t[k] = lane_get(s2[k], lane ^ o);
#pragma unroll
        for (int k = 0; k < 4; ++k) s2[k] += t[k]; }
    f32x4 gg[4], bb[4];
#pragma unroll
    for (int j = 0; j < 4; ++j) { gg[j] = *(const f32x4*)(g + 4 * lane + 256 * j); bb[j] = *(const f32x4*)(b + 4 * lane + 256 * j); }
#pragma unroll
    for (int k = 0; k < 4; ++k) { const float rstd = rsqrtf(s2[k] * (1.f / 1024.f) + LN_EPS);
        if (stat && lane == 0) { f32x2 st; st[0] = mean[k]; st[1] = rstd; stat[k] = st; }
#pragma unroll
        for (int j = 0; j < 4; ++j) {
            const f32x4 o = v[k][j] * rstd * gg[j] + bb[j];
            if (wr32) *(f32x4*)(z + k * 1024 + 4 * lane + 256 * j) = o;
            if (hb) { u32x2 q; q[0] = pk2(o[0], o[1]); q[1] = pk2(o[2], o[3]); *(u32x2*)(hb + k * 1024 + 4 * lane + 256 * j) = q; }
        } }
}

#define EPI_LOOP(u) _Pragma("unroll") for (int ai = 0; ai < 2; ++ai) _Pragma("unroll") for (int m = 0; m < 4; ++m) _Pragma("unroll") for (int bj = 0; bj < 2; ++bj)
#define EPI_ROW(u) ((u).pm * 256 + ai * 128 + wr * 64 + m * 16 + fr)
#define EPI_COL(u) ((u).pn * 256 + bj * 128 + wc * 32 + 8 * fq)
#define EPI_E ((ai * 4 + m) * 2 + bj)
#define EPI_ROW2(u) ((u).pm * 256 + ai * 128 + wr * 64 + m * 16 + fr)
#define EPI_GROUPS _Pragma("unroll") for (int ai = 0; ai < 2; ++ai) _Pragma("unroll") for (int mh = 0; mh < 2; ++mh)
#define EPI_IN_GROUP _Pragma("unroll") for (int mm = 0; mm < 2; ++mm) _Pragma("unroll") for (int bj = 0; bj < 2; ++bj)
#define EPI_GI (mm * 2 + bj)
#define EPI_PAIRS _Pragma("unroll") for (int ai = 0; ai < 2; ++ai) _Pragma("unroll") for (int m = 0; m < 4; ++m)
#define EPI_IN_PAIR _Pragma("unroll") for (int bj = 0; bj < 2; ++bj)

struct SchedG1 { const Params& P; int G, c;
    __device__ __forceinline__ bool next(int i, GUnit& u) const {
        const int L = i * G + c; if (L >= 128 * 12) return false;
        pg8::tile_of(L, 128, 12, u.pm, u.pn);
        u.A = (const char*)(P.ws + OFF_HB) + (size_t)u.pm * 256 * 2048; u.lda = 2048;
        u.B = (const char*)(WTP(WT_IN)) + (size_t)u.pn * 256 * 2048; u.ldb = 2048; u.nt = 16; u.kind = 0; return true; } };
struct EpiG1 { const Params& P;
    __device__ __forceinline__ void operator()(const f32x4 (&acc)[2][2][4][2], const GUnit& u, int wr, int wc, int fr, int fq) const {
        bf16_t* PS = WSP(bf16_t, OFF_PS); float* FL = WSP(float, OFF_FL);
        if (u.pn < 11) {
            const float qs = u.pn == 1 ? 0.18033688011112042f : (u.pn == 8 ? 0.18033688011112042f : 1.0f);
            EPI_LOOP(u) { const f32x4 v0 = acc[ai][bj][m][0] * qs, v1 = acc[ai][bj][m][1] * qs; u32x4 o; o[0] = pk2(v0[0], v0[1]); o[1] = pk2(v0[2], v0[3]); o[2] = pk2(v1[0], v1[1]); o[3] = pk2(v1[2], v1[3]);
                *(u32x4*)(PS + (size_t)EPI_ROW(u) * PSLD + EPI_COL(u)) = o; }
        } else if (wc == 0 && fq == 0) {
#pragma unroll
            for (int ai = 0; ai < 2; ++ai)
#pragma unroll
                for (int m = 0; m < 4; ++m) { const int bj = 0; *(f32x4*)(FL + (size_t)EPI_ROW(u) * 4) = acc[ai][0][m][0]; }
        } } };

struct SchedG2 { const Params& P; int G, c;
    __device__ __forceinline__ bool next(int i, GUnit& u) const {
        const int ti = i >> 3, st = i & 7, n = st >> 1; const int L = ti * G + c; if (L >= 128 * 4) return false;
        pg8::tile_of(L, 128, 4, u.pm, u.pn);
        if (!(st & 1)) { u.A = (const char*)(P.ws + OFF_YC) + (size_t)u.pm * 256 * 2048 + n * 512; u.lda = 2048;
            u.B = (const char*)(WTP(WT_BR)) + ((size_t)n * 1024 + u.pn * 256) * 512; u.ldb = 512; u.nt = 4; u.kind = 0; }
        else { u.A = (const char*)(P.ws + OFF_HB) + (size_t)u.pm * 256 * 2048; u.lda = 2048;
            u.B = (const char*)(WTP(WT_IN)) + ((size_t)2820 + n * 1024 + u.pn * 256) * 2048; u.ldb = 2048; u.nt = 16; u.kind = 1 + n; }
        return true; } };
struct EpiG2 { const Params& P;
    __device__ __forceinline__ void operator()(const f32x4 (&acc)[2][2][4][2], const GUnit& u, int wr, int wc, int fr, int fq) const {
        unsigned char* Sb = P.ws + OFF_G2S + (size_t)blockIdx.x * 393216;
        int fr_ = fr; asm volatile("" : "+v"(fr_));
        const unsigned tl16 = (unsigned)((wr * 4 + wc) * 64 + fq * 16 + fr_) * 16u;
#define G2_S(e) (*(u32x4*)(Sb + ({ unsigned o_ = tl16; asm volatile("" : "+v"(o_)); o_ + (e) * 8192u; })))
#define G2_M(e) (*(f32x4*)(Sb + 131072 + ({ unsigned o_ = tl16; asm volatile("" : "+v"(o_)); o_ + (e) * 8192u; })))
        bf16_t* MG = WSP(bf16_t, OFF_MG);
        if (u.kind == 0) {
            EPI_LOOP(u) { const f32x4 v0 = acc[ai][bj][m][0], v1 = acc[ai][bj][m][1]; u32x4 o; o[0] = pk2(v0[0], v0[1]); o[1] = pk2(v0[2], v0[3]); o[2] = pk2(v1[0], v1[1]); o[3] = pk2(v1[2], v1[3]);
                G2_S(EPI_E) = o; }
        } else {
            const int n = u.kind - 1;
#define G2_GATE_T0T1 const f32x4 g0 = acc[ai][bj][m][0], g1 = acc[ai][bj][m][1]; const u32x4 s = sv[EPI_GI]; f32x4 t0, t1; \
                    t0[0] = sigm(g0[0]) * bflo(s[0]); t0[1] = sigm(g0[1]) * bfhi(s[0]); t0[2] = sigm(g0[2]) * bflo(s[1]); t0[3] = sigm(g0[3]) * bfhi(s[1]); \
                    t1[0] = sigm(g1[0]) * bflo(s[2]); t1[1] = sigm(g1[1]) * bfhi(s[2]); t1[2] = sigm(g1[2]) * bflo(s[3]); t1[3] = sigm(g1[3]) * bfhi(s[3]);
#define G2_MB(e) (*(u32x4*)(Sb + 131072 + ({ unsigned o_ = tl16; asm volatile("" : "+v"(o_)); o_ + (e) * 8192u; })))
#define G2_ADDM const u32x4 mq = mv[EPI_GI]; t0[0] += bflo(mq[0]); t0[1] += bfhi(mq[0]); t0[2] += bflo(mq[1]); t0[3] += bfhi(mq[1]); t1[0] += bflo(mq[2]); t1[1] += bfhi(mq[2]); t1[2] += bflo(mq[3]); t1[3] += bfhi(mq[3]);
#define G2_PACK u32x4 o; o[0] = pk2(t0[0], t0[1]); o[1] = pk2(t0[2], t0[3]); o[2] = pk2(t1[0], t1[1]); o[3] = pk2(t1[2], t1[3]);
            if (n == 0) {
                EPI_GROUPS { u32x4 sv[4];
                    EPI_IN_GROUP { const int m = 2 * mh + mm; sv[EPI_GI] = G2_S(EPI_E); }
                    EPI_IN_GROUP { const int m = 2 * mh + mm; G2_GATE_T0T1 G2_PACK G2_MB(EPI_E) = o; }
                    __builtin_amdgcn_sched_barrier(0); }
            } else if (n < 3) {
                EPI_PAIRS { u32x4 sv[2], mv[2];
                    EPI_IN_PAIR { sv[bj] = G2_S(EPI_E); mv[bj] = G2_MB(EPI_E); }
                    EPI_IN_PAIR { const int mm = 0; G2_GATE_T0T1 G2_ADDM G2_PACK G2_MB(EPI_E) = o; }
                    __builtin_amdgcn_sched_barrier(0); }
            } else {
                EPI_PAIRS { u32x4 sv[2], mv[2];
                    EPI_IN_PAIR { sv[bj] = G2_S(EPI_E); mv[bj] = G2_MB(EPI_E); }
                    EPI_IN_PAIR { const int mm = 0; G2_GATE_T0T1 G2_ADDM G2_PACK *(u32x4*)(MG + (size_t)EPI_ROW(u) * 1024 + EPI_COL(u)) = o; }
                    __builtin_amdgcn_sched_barrier(0); }
            }
        } } };

struct SchedG3 { const Params& P; int G, c;
    __device__ __forceinline__ bool next(int i, GUnit& u) const {
        const int L = i * G + c; if (L >= 128 * 4) return false;
        pg8::tile_of(L, 128, 4, u.pm, u.pn);
        u.A = (const char*)(P.ws + OFF_MG) + (size_t)u.pm * 256 * 2048; u.lda = 2048;
        u.B = (const char*)(WTP(WT_OUT)) + (size_t)u.pn * 256 * 2048; u.ldb = 2048; u.nt = 16; u.kind = 0; return true; } };
#define LN_APPLY(zv, st, gv, bv) (((zv) - (st)[0]) * (st)[1] * (gv) + (bv))
struct EpiG3 { const Params& P; const float* hsrc; const float* lng; const float* lnb;
    __device__ __forceinline__ void operator()(const f32x4 (&acc)[2][2][4][2], const GUnit& u, int wr, int wc, int fr, int fq) const {
        if (lng == nullptr) {
            EPI_GROUPS {
                f32x4 ha[4], hb4[4];
                EPI_IN_GROUP { const int m = 2 * mh + mm; const size_t o = (size_t)EPI_ROW(u) * 1024 + EPI_COL(u); ha[EPI_GI] = *(const f32x4*)(hsrc + o); hb4[EPI_GI] = *(const f32x4*)(hsrc + o + 4); }
                EPI_IN_GROUP { const int m = 2 * mh + mm; const size_t o = (size_t)EPI_ROW(u) * 1024 + EPI_COL(u);
                    *(f32x4*)(P.out + o) = ha[EPI_GI] * ALPHA + acc[ai][bj][m][0]; *(f32x4*)(P.out + o + 4) = hb4[EPI_GI] * ALPHA + acc[ai][bj][m][1]; }
                __builtin_amdgcn_sched_barrier(0); }
        } else {
            const f32x2* STAT = WSP(f32x2, OFF_STAT);
            EPI_PAIRS {
                const int row = EPI_ROW2(u); const f32x2 st = STAT[row];
                f32x4 ha[2], hb4[2], g0[2], g1[2], b0[2], b1[2];
                EPI_IN_PAIR { const int col = EPI_COL(u); const size_t o = (size_t)row * 1024 + col; ha[bj] = *(const f32x4*)(hsrc + o); hb4[bj] = *(const f32x4*)(hsrc + o + 4);
                    g0[bj] = *(const f32x4*)(lng + col); g1[bj] = *(const f32x4*)(lng + col + 4); b0[bj] = *(const f32x4*)(lnb + col); b1[bj] = *(const f32x4*)(lnb + col + 4); }
                EPI_IN_PAIR { const size_t o = (size_t)row * 1024 + EPI_COL(u);
                    *(f32x4*)(P.out + o) = LN_APPLY(ha[bj], st, g0[bj], b0[bj]) * ALPHA + acc[ai][bj][m][0]; *(f32x4*)(P.out + o + 4) = LN_APPLY(hb4[bj], st, g1[bj], b1[bj]) * ALPHA + acc[ai][bj][m][1]; }
                __builtin_amdgcn_sched_barrier(0); }
        } } };

struct SchedG4 { const Params& P; int G, c;
    __device__ __forceinline__ bool next(int i, GUnit& u) const {
        const int L = i * G + c; if (L >= 128 * 16) return false;
        pg8::tile_of(L, 128, 16, u.pm, u.pn);
        u.A = (const char*)(P.ws + OFF_HB) + (size_t)u.pm * 256 * 2048; u.lda = 2048;
        u.B = (const char*)(WTP(WT_W1)) + (size_t)u.pn * 256 * 2048; u.ldb = 2048; u.nt = 16; u.kind = 0; return true; } };
struct EpiG4 { const Params& P;
    __device__ __forceinline__ void operator()(const f32x4 (&acc)[2][2][4][2], const GUnit& u, int wr, int wc, int fr, int fq) const {
        bf16_t* U = WSP(bf16_t, OFF_U);
        EPI_LOOP(u) { f32x4 v0 = acc[ai][bj][m][0], v1 = acc[ai][bj][m][1];
#pragma unroll
            for (int j = 0; j < 4; ++j) { const float a = fmaxf(v0[j], 0.f), b = fmaxf(v1[j], 0.f); v0[j] = a * a; v1[j] = b * b; }
            u32x4 o; o[0] = pk2(v0[0], v0[1]); o[1] = pk2(v0[2], v0[3]); o[2] = pk2(v1[0], v1[1]); o[3] = pk2(v1[2], v1[3]);
            *(u32x4*)(U + (size_t)EPI_ROW(u) * 4096 + EPI_COL(u)) = o; } } };

struct SchedG5 { const Params& P; int G, c;
    __device__ __forceinline__ bool next(int i, GUnit& u) const {
        const int ti = i / 3, st = i % 3; const int L = ti * G + c; if (L >= 128 * 4) return false;
        pg8::tile_of(L, 128, 4, u.pm, u.pn); u.kind = st;
        if (st == 0) { u.A = (const char*)(P.ws + OFF_YC) + (size_t)u.pm * 256 * 512; u.lda = 512; u.B = (const char*)(WTP(WT_PL)) + (size_t)u.pn * 256 * 512; u.ldb = 512; u.nt = 4; }
        else if (st == 1) { u.A = (const char*)(P.ws + OFF_HB) + (size_t)u.pm * 256 * 2048; u.lda = 2048; u.B = (const char*)(WTP(WT_PG)) + (size_t)u.pn * 256 * 2048; u.ldb = 2048; u.nt = 16; }
        else { u.A = (const char*)(P.ws + OFF_U) + (size_t)u.pm * 256 * 8192; u.lda = 8192; u.B = (const char*)(WTP(WT_W2)) + (size_t)u.pn * 256 * 8192; u.ldb = 8192; u.nt = 64; }
        return true; } };
struct EpiG5 { const Params& P; const float* lng; const float* lnb;
    __device__ __forceinline__ void operator()(const f32x4 (&acc)[2][2][4][2], const GUnit& u, int wr, int wc, int fr, int fq) const {
        unsigned char* Sb = P.ws + OFF_G5S + (size_t)blockIdx.x * 131072;
        int fr_ = fr; asm volatile("" : "+v"(fr_));
        const unsigned tl16 = (unsigned)((wr * 4 + wc) * 64 + fq * 16 + fr_) * 16u;
        if (u.kind == 0) {
            EPI_LOOP(u) { const f32x4 v0 = acc[ai][bj][m][0], v1 = acc[ai][bj][m][1]; u32x4 o; o[0] = pk2(v0[0], v0[1]); o[1] = pk2(v0[2], v0[3]); o[2] = pk2(v1[0], v1[1]); o[3] = pk2(v1[2], v1[3]);
                G2_S(EPI_E) = o; }
        } else if (u.kind == 1) {
            EPI_GROUPS {
                u32x4 sv[4];
                EPI_IN_GROUP { const int m = 2 * mh + mm; sv[EPI_GI] = G2_S(EPI_E); }
                EPI_IN_GROUP { const int m = 2 * mh + mm; const f32x4 g0 = acc[ai][bj][m][0], g1 = acc[ai][bj][m][1]; const u32x4 s = sv[EPI_GI]; u32x4 o;
                    o[0] = pk2(sigm(g0[0]) * bflo(s[0]), sigm(g0[1]) * bfhi(s[0])); o[1] = pk2(sigm(g0[2]) * bflo(s[1]), sigm(g0[3]) * bfhi(s[1]));
                    o[2] = pk2(sigm(g1[0]) * bflo(s[2]), sigm(g1[1]) * bfhi(s[2])); o[3] = pk2(sigm(g1[2]) * bflo(s[3]), sigm(g1[3]) * bfhi(s[3]));
                    G2_S(EPI_E) = o; }
                __builtin_amdgcn_sched_barrier(0); }
        } else {
            const f32x2* STAT = WSP(f32x2, OFF_STAT);
            EPI_PAIRS {
                const int row = EPI_ROW2(u); const f32x2 st = STAT[row];
                u32x4 sv[2]; f32x4 ha[2], hb4[2], g0[2], g1[2], b0[2], b1[2];
                EPI_IN_PAIR { const int col = EPI_COL(u); const size_t o = (size_t)row * 1024 + col; sv[bj] = G2_S(EPI_E); ha[bj] = *(const f32x4*)(P.out + o); hb4[bj] = *(const f32x4*)(P.out + o + 4);
                    g0[bj] = *(const f32x4*)(lng + col); g1[bj] = *(const f32x4*)(lng + col + 4); b0[bj] = *(const f32x4*)(lnb + col); b1[bj] = *(const f32x4*)(lnb + col + 4); }
                EPI_IN_PAIR { const size_t o = (size_t)row * 1024 + EPI_COL(u); const u32x4 s = sv[bj];
                    f32x4 p0, p1; p0[0] = bflo(s[0]); p0[1] = bfhi(s[0]); p0[2] = bflo(s[1]); p0[3] = bfhi(s[1]); p1[0] = bflo(s[2]); p1[1] = bfhi(s[2]); p1[2] = bflo(s[3]); p1[3] = bfhi(s[3]);
                    *(f32x4*)(P.out + o) = LN_APPLY(ha[bj], st, g0[bj], b0[bj]) * ALPHA + acc[ai][bj][m][0] + p0; *(f32x4*)(P.out + o + 4) = LN_APPLY(hb4[bj], st, g1[bj], b1[bj]) * ALPHA + acc[ai][bj][m][1] + p1; }
                __builtin_amdgcn_sched_barrier(0); }
        } } };

struct S5Lane { float lbr, lbi; float bbr[16], bbi[16]; };
__device__ __forceinline__ void s5_setup(const Params& P, int L, int g, int p, S5Lane& s) {
    const float dt = expf(P.in[IS5_LDT][L * 16 + g]);
    const float lr = P.in[IS5_LRE][(L * 16 + g) * 64 + p], li = P.in[IS5_LIM][(L * 16 + g) * 64 + p];
    const float mag = expf(lr * dt), ang = li * dt;
    s.lbr = mag * cosf(ang); s.lbi = mag * sinf(ang);
    const float den = lr * lr + li * li, nr = s.lbr - 1.0f;
    const float fre = (nr * lr + s.lbi * li) / den, fim = (s.lbi * lr - nr * li) / den;
    const float* br = P.in[IS5_BRE] + ((size_t)(L * 16 + g) * 64 + p) * 16; const float* bi = P.in[IS5_BIM] + ((size_t)(L * 16 + g) * 64 + p) * 16;
#pragma unroll
    for (int q = 0; q < 4; ++q) { const f32x4 a = *(const f32x4*)(br + 4 * q), b = *(const f32x4*)(bi + 4 * q);
#pragma unroll
        for (int j = 0; j < 4; ++j) { s.bbr[4 * q + j] = fre * a[j] - fim * b[j]; s.bbi[4 * q + j] = fre * b[j] + fim * a[j]; } }
}
#define S5_STEP(s, wq, xr, xi) do { float bur = 0.f, bui = 0.f; \
    _Pragma("unroll") for (int q = 0; q < 8; ++q) { const float u0 = bflo(wq[q]), u1 = bfhi(wq[q]); \
        bur = fmaf(s.bbr[2 * q], u0, bur); bui = fmaf(s.bbi[2 * q], u0, bui); bur = fmaf(s.bbr[2 * q + 1], u1, bur); bui = fmaf(s.bbi[2 * q + 1], u1, bui); } \
    const float nxr = s.lbr * xr - s.lbi * xi + bur, nxi = s.lbr * xi + s.lbi * xr + bui; xr = nxr; xi = nxi; } while (0)

__device__ __forceinline__ void s5_pass1(const Params& P, int L, int task, int lane) {
    const int g = task & 15, C = (task >> 4) & 15, b = task >> 8;
    S5Lane s; s5_setup(P, L, g, lane, s);
    const bf16_t* PS = WSP(bf16_t, OFF_PS);
    f32x2* L32 = WSP(f32x2, OFF_L32); f32x2* E256 = WSP(f32x2, OFF_E256);
    float xr = 0.f, xi = 0.f;
    const size_t tok0 = (size_t)b * SEQ + C * 256;
    for (int sub = 0; sub < 4; ++sub) {
        const u32x4* src = (const u32x4*)(PS + (tok0 + sub * 64 + lane) * PSLD + g * 16);
        const u32x4 wa = src[0], wb = src[1];
        for (int t = 0; t < 64; ++t) {
            unsigned wq[8];
#pragma unroll
            for (int q = 0; q < 4; ++q) { wq[q] = __builtin_amdgcn_readlane(wa[q], t); wq[4 + q] = __builtin_amdgcn_readlane(wb[q], t); }
            S5_STEP(s, wq, xr, xi);
            if ((t & 31) == 31) { f32x2 o; o[0] = xr; o[1] = xi; L32[(((size_t)b * 128 + C * 8 + sub * 2 + (t >> 5)) * 16 + g) * 64 + lane] = o; }
        }
    }
    { f32x2 o; o[0] = xr; o[1] = xi; E256[(((size_t)b * 16 + C) * 16 + g) * 64 + lane] = o; }
}
__device__ __forceinline__ void cmul(float& ar, float& ai, float br, float bi) { const float r = ar * br - ai * bi, i = ar * bi + ai * br; ar = r; ai = i; }
__device__ __forceinline__ float gelu_tanh(float x) { return 0.5f * x * (1.f + tanhf(0.7978845608028654f * (x + 0.044715f * x * x * x))); }

__device__ __forceinline__ void s5_pass3(const Params& P, int L, int task, LAS unsigned char* lds, int tid) {
    const int lane = tid & 63, w = tid >> 6, b = task >> 5, c128 = task & 31, C = c128 >> 1, j0 = (c128 & 1) * 4;
    LAS bf16_t* Xs = (LAS bf16_t*)lds + w * (32 * 136); LAS bf16_t* Yg = (LAS bf16_t*)(lds + 69632);
    const bf16_t* PS = WSP(bf16_t, OFF_PS); const f32x2* L32 = WSP(f32x2, OFF_L32); const f32x2* E256 = WSP(f32x2, OFF_E256);
    const int h = lane & 15, quad = lane >> 4;
    const size_t tokb = (size_t)b * SEQ + c128 * 128;
    for (int gi = 0; gi < 2; ++gi) {
        const int g = 2 * w + gi;
        S5Lane s; s5_setup(P, L, g, lane, s);
        float xr = 0.f, xi = 0.f;
        { float pr = s.lbr, pi = s.lbi;
#pragma unroll
          for (int q = 0; q < 5; ++q) cmul(pr, pi, pr, pi);
          float p4r = pr, p4i = pi; cmul(p4r, p4i, p4r, p4i); cmul(p4r, p4i, p4r, p4i);
          float qr = p4r, qi = p4i; cmul(qr, qi, qr, qi);
          f32x2 ev[15];
#pragma unroll
          for (int cc = 0; cc < 15; ++cc) { ev[cc] = (f32x2){0.f, 0.f}; if (cc < C) ev[cc] = E256[(((size_t)b * 16 + cc) * 16 + g) * 64 + lane]; }
          f32x2 el = (f32x2){0.f, 0.f}; if (j0) el = L32[(((size_t)b * 128 + C * 8 + 3) * 16 + g) * 64 + lane];
#pragma unroll
          for (int cc = 0; cc < 15; ++cc) if (cc < C) { cmul(xr, xi, qr, qi); xr += ev[cc][0]; xi += ev[cc][1]; }
          if (j0) { cmul(xr, xi, p4r, p4i); xr += el[0]; xi += el[1]; } }
        bf16x8 bfr[4];
#pragma unroll
        for (int ks = 0; ks < 4; ++ks) {
            const float* cp = (ks < 2 ? P.in[IS5_CRE] : P.in[IS5_CIM]) + ((size_t)(L * 16 + g) * 16 + h) * 64 + (ks & 1) * 32 + quad * 8;
            const f32x4 c0 = *(const f32x4*)cp, c1 = *(const f32x4*)(cp + 4); const float sg = ks < 2 ? 1.f : -1.f;
            u32x4 o; o[0] = pk2(sg * c0[0], sg * c0[1]); o[1] = pk2(sg * c0[2], sg * c0[3]); o[2] = pk2(sg * c1[0], sg * c1[1]); o[3] = pk2(sg * c1[2], sg * c1[3]);
            bfr[ks] = __builtin_bit_cast(bf16x8, o);
        }
        const float dd = P.in[IS5_D][(L * 16 + g) * 16 + h];
        for (int sub = 0; sub < 4; ++sub) {
            const size_t tok0 = tokb + sub * 32;
            const u32x4* src = (const u32x4*)(PS + (tok0 + (lane & 31)) * PSLD + g * 16);
            const u32x4 wa = src[0], wb = src[1];
            LAS bf16_t* Uw = (LAS bf16_t*)(lds + 137216) + w * 512;
            *(LAS u32x4*)(Uw + (lane & 31) * 16) = wa; *(LAS u32x4*)(Uw + (lane & 31) * 16 + 8) = wb;
            for (int t = 0; t < 32; ++t) {
                unsigned wq[8];
#pragma unroll
                for (int q = 0; q < 4; ++q) { wq[q] = __builtin_amdgcn_readlane(wa[q], t); wq[4 + q] = __builtin_amdgcn_readlane(wb[q], t); }
                S5_STEP(s, wq, xr, xi);
                const unsigned pk = pk2(xr, xi);
                Xs[t * 136 + lane] = (bf16_t)(pk & 0xffffu); Xs[t * 136 + 64 + lane] = (bf16_t)(pk >> 16);
            }
#pragma unroll
            for (int tb = 0; tb < 2; ++tb) {
                f32x4 acc = {0.f, 0.f, 0.f, 0.f};
#pragma unroll
                for (int ks = 0; ks < 4; ++ks) { const bf16x8 a = *(const LAS bf16x8*)(Xs + (tb * 16 + h) * 136 + ks * 32 + quad * 8); acc = __builtin_amdgcn_mfma_f32_16x16x32_bf16(a, bfr[ks], acc, 0, 0, 0); }
#pragma unroll
                for (int r = 0; r < 4; ++r) { const int t = tb * 16 + quad * 4 + r;
                    const float uu = bf1(Uw[t * 16 + h]);
                    Yg[(sub * 32 + t) * 264 + g * 16 + h] = (bf16_t)(pk2(gelu_tanh(acc[r] + dd * uu), 0.f) & 0xffffu); }
            }
        }
    }
    __syncthreads();
    {
        bf16_t* YC = WSP(bf16_t, OFF_YC);
#pragma unroll 1
        for (int sub = 0; sub < 4; ++sub) {
            const LAS bf16_t* Ys = Yg + sub * 32 * 264;
            LAS bf16_t* So = (LAS bf16_t*)lds + (sub & 1) * (32 * 264);
            int hl = h; asm volatile("" : "+v"(hl));
#pragma unroll
            for (int nb = 0; nb < 2; ++nb) {
                const int n = 32 * w + 16 * nb + hl; const bf16_t* wrow = WTP(WT_GLU) + (size_t)n * 256 + quad * 8; const float gb = P.in[IS5_GLUB][L * 256 + n];
                f32x4 acc[2] = {{0.f, 0.f, 0.f, 0.f}, {0.f, 0.f, 0.f, 0.f}};
#pragma unroll
                for (int ks = 0; ks < 8; ++ks) { const bf16x8 bb = *(const bf16x8*)(wrow + ks * 32);
#pragma unroll
                    for (int tb = 0; tb < 2; ++tb) { const bf16x8 a = *(const LAS bf16x8*)(Ys + (tb * 16 + h) * 264 + ks * 32 + quad * 8); acc[tb] = __builtin_amdgcn_mfma_f32_16x16x32_bf16(a, bb, acc[tb], 0, 0, 0); } }
#pragma unroll
                for (int tb = 0; tb < 2; ++tb)
#pragma unroll
                    for (int r = 0; r < 4; ++r) { const int t = tb * 16 + quad * 4 + r; const float y = bf1(Ys[t * 264 + n]);
                        So[t * 264 + n] = (bf16_t)(pk2(y * sigm(acc[tb][r] + gb), 0.f) & 0xffffu); }
            }
            __syncthreads();
#pragma unroll
            for (int i = 0; i < 2; ++i) { int tl2 = tid; asm volatile("" : "+v"(tl2)); const int e = tl2 + 512 * i, t = e >> 5, c8 = (e & 31) * 8;
                *(u32x4*)(YC + (tokb + sub * 32 + t) * 1024 + c8) = *(const LAS u32x4*)(So + t * 264 + c8); }
        }
    }
    __syncthreads();
}

__device__ __forceinline__ void cl_task(const Params& P, int L, int task, int lane) {
    const int b = task >> 6, tl = task & 63; const float* FL = WSP(float, OFF_FL); float* CL = WSP(float, OFF_CL);
    const f32x4 f = *(const f32x4*)(FL + ((size_t)b * SEQ + tl * 64 + lane) * 4);
#pragma unroll
    for (int h = 0; h < 4; ++h) {
        const float x = f[h] + P.in[IFOX_B][L * 4 + h];
        float v = fminf(x, 0.f) - log1pf(expf(-fabsf(x)));
#pragma unroll
        for (int o = 1; o < 64; o <<= 1) { const float n = lane_get(v, (lane - o) & 63); if (lane >= o) v += n; }
        CL[((size_t)b * 4 + h) * SEQ + tl * 64 + lane] = v;
    }
}

__device__ __forceinline__ void rwkv_prep(const Params& P, int L, int task, LAS unsigned char* lds, int tid) {
    const int lane = tid & 63, w = tid >> 6; const size_t tok0 = (size_t)task * 32;
    LAS bf16_t* At = (LAS bf16_t*)lds; LAS bf16_t* Aa = (LAS bf16_t*)(lds + 4608); LAS bf16_t* Ag = (LAS bf16_t*)(lds + 9216);
    LAS float* Lw = (LAS float*)(lds + 17920); LAS float* La = (LAS float*)(lds + 51200); LAS float* Lg = (LAS float*)(lds + 84480);
    const bf16_t* PS = WSP(bf16_t, OFF_PS); const float* mu = P.in[IRW_MU] + (size_t)L * 1024;
#pragma unroll
    for (int i = 0; i < 2; ++i) {
        const int e = tid + 512 * i, tl = e >> 5, cg = e & 31, c = cg * 8; const size_t tok = tok0 + tl; const int rc = 768 + c;
        const u32x4 cu = *(const u32x4*)(PS + tok * PSLD + 1024 + rc);
        const bool first = (tok % SEQ) == 0;
        const u32x4 pv = *(const u32x4*)(PS + (tok - (first ? 0 : 1)) * PSLD + 1024 + rc);
        const f32x4 m0 = *(const f32x4*)(mu + rc), m1 = *(const f32x4*)(mu + rc + 4);
        float xs[8];
#pragma unroll
        for (int j = 0; j < 4; ++j) { const float c0 = bflo(cu[j]), c1 = bfhi(cu[j]); const float p0 = first ? 0.f : bflo(pv[j]), p1 = first ? 0.f : bfhi(pv[j]);
            const float ma = j < 2 ? m0[2 * j] : m1[2 * j - 4], mb = j < 2 ? m0[2 * j + 1] : m1[2 * j - 3];
            xs[2 * j] = c0 + (p0 - c0) * ma; xs[2 * j + 1] = c1 + (p1 - c1) * mb; }
        u32x4 o;
        if (c < 64) {
#pragma unroll
            for (int j = 0; j < 4; ++j) o[j] = pk2(1.f - 2.f * __builtin_amdgcn_rcpf(1.f + __expf(2.f * xs[2 * j])), 1.f - 2.f * __builtin_amdgcn_rcpf(1.f + __expf(2.f * xs[2 * j + 1])));
            *(LAS u32x4*)(At + tl * 72 + c) = o;
        } else if (c < 128) {
#pragma unroll
            for (int j = 0; j < 4; ++j) o[j] = pk2(xs[2 * j], xs[2 * j + 1]);
            *(LAS u32x4*)(Aa + tl * 72 + c - 64) = o;
        } else {
#pragma unroll
            for (int j = 0; j < 4; ++j) o[j] = pk2(sigm(xs[2 * j]), sigm(xs[2 * j + 1]));
            *(LAS u32x4*)(Ag + tl * 136 + c - 128) = o;
        }
    }
    __syncthreads();
    {
        const int h = lane & 15, quad = lane >> 4;
#pragma unroll
        for (int nb = 0; nb < 2; ++nb) {
            const int n = 32 * w + 16 * nb + h;
            f32x4 aw[2] = {{0.f, 0.f, 0.f, 0.f}, {0.f, 0.f, 0.f, 0.f}}, aa[2] = {{0.f, 0.f, 0.f, 0.f}, {0.f, 0.f, 0.f, 0.f}}, ag[2] = {{0.f, 0.f, 0.f, 0.f}, {0.f, 0.f, 0.f, 0.f}};
#pragma unroll
            for (int ks = 0; ks < 2; ++ks) {
                const bf16x8 bw = *(const bf16x8*)(WTP(WT_RW2) + (size_t)n * 64 + ks * 32 + quad * 8), ba = *(const bf16x8*)(WTP(WT_RA2) + (size_t)n * 64 + ks * 32 + quad * 8);
#pragma unroll
                for (int tb = 0; tb < 2; ++tb) {
                    aw[tb] = __builtin_amdgcn_mfma_f32_16x16x32_bf16(*(const LAS bf16x8*)(At + (tb * 16 + h) * 72 + ks * 32 + quad * 8), bw, aw[tb], 0, 0, 0);
                    aa[tb] = __builtin_amdgcn_mfma_f32_16x16x32_bf16(*(const LAS bf16x8*)(Aa + (tb * 16 + h) * 72 + ks * 32 + quad * 8), ba, aa[tb], 0, 0, 0); }
            }
#pragma unroll
            for (int ks = 0; ks < 4; ++ks) {
                const bf16x8 bg = *(const bf16x8*)(WTP(WT_RG2) + (size_t)n * 128 + ks * 32 + quad * 8);
#pragma unroll
                for (int tb = 0; tb < 2; ++tb) ag[tb] = __builtin_amdgcn_mfma_f32_16x16x32_bf16(*(const LAS bf16x8*)(Ag + (tb * 16 + h) * 136 + ks * 32 + quad * 8), bg, ag[tb], 0, 0, 0);
            }
#pragma unroll
            for (int tb = 0; tb < 2; ++tb)
#pragma unroll
                for (int r = 0; r < 4; ++r) { const int t = tb * 16 + quad * 4 + r; Lw[t * 260 + n] = aw[tb][r]; La[t * 260 + n] = aa[tb][r]; Lg[t * 260 + n] = ag[tb][r];
                }
        }
    }
    __syncthreads();
    {
        const int tl = tid >> 4, q16 = tid & 15; const size_t tok = tok0 + tl; const bool first = (tok % SEQ) == 0;
        const bf16_t* cur = PS + tok * PSLD + 1024; const bf16_t* prv = PS + (tok - (first ? 0 : 1)) * PSLD + 1024;
        float* DEC = WSP(float, OFF_RW_DEC); bf16_t* RR = WSP(bf16_t, OFF_RW_R); bf16_t* RK = WSP(bf16_t, OFF_RW_K); bf16_t* RV = WSP(bf16_t, OFF_RW_V);
        bf16_t* RKK = WSP(bf16_t, OFF_RW_KK); bf16_t* RB = WSP(bf16_t, OFF_RW_B); bf16_t* RG = WSP(bf16_t, OFF_RW_G);
#define UNPK8(dst, q) do { dst[0] = bflo(q[0]); dst[1] = bfhi(q[0]); dst[2] = bflo(q[1]); dst[3] = bfhi(q[1]); dst[4] = bflo(q[2]); dst[5] = bfhi(q[2]); dst[6] = bflo(q[3]); dst[7] = bfhi(q[3]); } while (0)
#define SHIFT8(xo, off) do { const u32x4 a_ = *(const u32x4*)(cur + (off) + c), b_ = *(const u32x4*)(prv + (off) + c); const f32x4 m0_ = *(const f32x4*)(mu + (off) + c), m1_ = *(const f32x4*)(mu + (off) + c + 4); \
            float cu_[8], pv_[8]; UNPK8(cu_, a_); UNPK8(pv_, b_); _Pragma("unroll") for (int j = 0; j < 8; ++j) xo[j] = cu_[j] + ((first ? 0.f : pv_[j]) - cu_[j]) * (j < 4 ? m0_[j & 3] : m1_[j & 3]); } while (0)
#define PK8(v) ({ u32x4 o_; o_[0] = pk2(v[0], v[1]); o_[1] = pk2(v[2], v[3]); o_[2] = pk2(v[4], v[5]); o_[3] = pk2(v[6], v[7]); o_; })
#pragma unroll
        for (int ps = 0; ps < 2; ++ps) {
            const int hh = 2 * ps + (q16 >> 3), c = hh * 64 + (q16 & 7) * 8;
            float xr[8], xk[8], xv[8];
            SHIFT8(xr, 0); SHIFT8(xk, 256); SHIFT8(xv, 512);
            float w0[8], a0[8], kkw[8], kaw[8], lw[8], la[8], lg[8];
#define LD8G(dst, p) do { const f32x4 a_ = *(const f32x4*)(p), b_ = *(const f32x4*)((p) + 4); _Pragma("unroll") for (int j = 0; j < 4; ++j) { dst[j] = a_[j]; dst[4 + j] = b_[j]; } } while (0)
#define LD8L(dst, p) do { const f32x4 a_ = *(const LAS f32x4*)(p), b_ = *(const LAS f32x4*)((p) + 4); _Pragma("unroll") for (int j = 0; j < 4; ++j) { dst[j] = a_[j]; dst[4 + j] = b_[j]; } } while (0)
            LD8G(w0, P.in[IRW_W0] + L * 256 + c); LD8G(a0, P.in[IRW_A0] + L * 256 + c); LD8G(kkw, P.in[IRW_KK] + L * 256 + c); LD8G(kaw, P.in[IRW_KA] + L * 256 + c);
            LD8L(lw, Lw + tl * 260 + c); LD8L(la, La + tl * 260 + c); LD8L(lg, Lg + tl * 260 + c);
            float dec[8], av[8], kx[8], kn[8]; float ss = 0.f;
#pragma unroll
            for (int j = 0; j < 8; ++j) {
                const float wl = w0[j] + lw[j];
                const float wv = -(fmaxf(-wl, 0.f) + __logf(1.f + __expf(-fabsf(wl)))) - 0.5f;
                dec[j] = __expf(-__expf(wv));
                av[j] = sigm(a0[j] + la[j]);
                kx[j] = xk[j] * kkw[j]; ss += kx[j] * kx[j];
                kn[j] = xk[j] * (1.f + (av[j] - 1.f) * kaw[j]);
            }
            ss += __builtin_bit_cast(float, __builtin_amdgcn_update_dpp(0, __builtin_bit_cast(int, ss), 0xB1, 0xf, 0xf, false));
            ss += __builtin_bit_cast(float, __builtin_amdgcn_update_dpp(0, __builtin_bit_cast(int, ss), 0x4E, 0xf, 0xf, false));
            ss += __builtin_bit_cast(float, __builtin_amdgcn_update_dpp(0, __builtin_bit_cast(int, ss), 0x141, 0xf, 0xf, false));
            const float inv = __builtin_amdgcn_rcpf(fmaxf(__builtin_amdgcn_sqrtf(ss), 1e-12f));
            float kkn[8], bv[8];
#pragma unroll
            for (int j = 0; j < 8; ++j) { kkn[j] = kx[j] * inv; bv[j] = kkn[j] * av[j]; }
            const size_t o = tok * 256 + c;
            { f32x4 d4; d4[0] = dec[0]; d4[1] = dec[1]; d4[2] = dec[2]; d4[3] = dec[3]; *(f32x4*)(DEC + o) = d4; d4[0] = dec[4]; d4[1] = dec[5]; d4[2] = dec[6]; d4[3] = dec[7]; *(f32x4*)(DEC + o + 4) = d4; }
            *(u32x4*)(RR + o) = PK8(xr); *(u32x4*)(RK + o) = PK8(kn); *(u32x4*)(RV + o) = PK8(xv); *(u32x4*)(RKK + o) = PK8(kkn); *(u32x4*)(RB + o) = PK8(bv); *(u32x4*)(RG + o) = PK8(lg);
        }
#undef UNPK8
#undef SHIFT8
#undef PK8
#undef LD8G
#undef LD8L
    }
    __syncthreads();
}

constexpr int RS_BUF = 43008, RS_Y = 2 * RS_BUF;
struct RwLoad { u32x2 r, k, kk, b; f32x4 d; bf16_t v; };
__device__ __forceinline__ void rw_load(const Params& P, int b, int h, int qtr, int chunk, int tid, RwLoad& x) {
    const int t = tid >> 4, c4 = (tid & 15) * 4; const size_t tok = (size_t)b * SEQ + chunk * 32 + t; const size_t o = tok * 256 + h * 64 + c4;
    x.r = *(const u32x2*)(WSP(bf16_t, OFF_RW_R) + o); x.k = *(const u32x2*)(WSP(bf16_t, OFF_RW_K) + o); x.kk = *(const u32x2*)(WSP(bf16_t, OFF_RW_KK) + o);
    x.b = *(const u32x2*)(WSP(bf16_t, OFF_RW_B) + o); x.d = *(const f32x4*)(WSP(float, OFF_RW_DEC) + o);
    x.v = WSP(bf16_t, OFF_RW_V)[tok * 256 + h * 64 + qtr * 16 + (tid & 15)];
}
__device__ __forceinline__ void rw_store(LAS unsigned char* buf, int tid, const RwLoad& x) {
    const int t = tid >> 4, c4 = (tid & 15) * 4;
    f32x4 v; v[0] = bflo(x.r[0]); v[1] = bfhi(x.r[0]); v[2] = bflo(x.r[1]); v[3] = bfhi(x.r[1]); *(LAS f32x4*)(buf + (t * 64 + c4) * 4) = v;
    *(LAS f32x4*)(buf + 8192 + (t * 64 + c4) * 4) = x.d;
    v[0] = bflo(x.k[0]); v[1] = bfhi(x.k[0]); v[2] = bflo(x.k[1]); v[3] = bfhi(x.k[1]); *(LAS f32x4*)(buf + 16384 + (t * 64 + c4) * 4) = v;
    v[0] = bflo(x.kk[0]); v[1] = bfhi(x.kk[0]); v[2] = bflo(x.kk[1]); v[3] = bfhi(x.kk[1]); *(LAS f32x4*)(buf + 24576 + (t * 64 + c4) * 4) = v;
    v[0] = bflo(x.b[0]); v[1] = bfhi(x.b[0]); v[2] = bflo(x.b[1]); v[3] = bfhi(x.b[1]); *(LAS f32x4*)(buf + 32768 + (t * 64 + c4) * 4) = v;
    *(LAS float*)(buf + 40960 + (t * 16 + (tid & 15)) * 4) = bf1(x.v);
}
struct RwStep { f32x4 kk4, w4, k4, b4, r4; float vv; };
__device__ __forceinline__ void rw_read(const LAS unsigned char* buf, int t, int kq, int row, RwStep& s) {
    s.kk4 = *(const LAS f32x4*)(buf + 24576 + (t * 64 + kq * 4) * 4); s.w4 = *(const LAS f32x4*)(buf + 8192 + (t * 64 + kq * 4) * 4);
    s.k4 = *(const LAS f32x4*)(buf + 16384 + (t * 64 + kq * 4) * 4); s.b4 = *(const LAS f32x4*)(buf + 32768 + (t * 64 + kq * 4) * 4);
    s.r4 = *(const LAS f32x4*)(buf + (t * 64 + kq * 4) * 4); s.vv = *(const LAS float*)(buf + 40960 + (t * 16 + row) * 4);
}
struct RwLoad8 { u32x4 r, k, kk, b; f32x4 d0, d1; unsigned v; };
__device__ __forceinline__ void rw_load8(const Params& P, int b, int h, int qtr, int chunk, int lt, RwLoad8& x) {
    const int t = lt >> 3, c8 = (lt & 7) * 8; const size_t tok = (size_t)b * SEQ + chunk * 32 + t; const size_t o = tok * 256 + h * 64 + c8;
    x.r = *(const u32x4*)(WSP(bf16_t, OFF_RW_R) + o); x.k = *(const u32x4*)(WSP(bf16_t, OFF_RW_K) + o); x.kk = *(const u32x4*)(WSP(bf16_t, OFF_RW_KK) + o);
    x.b = *(const u32x4*)(WSP(bf16_t, OFF_RW_B) + o); x.d0 = *(const f32x4*)(WSP(float, OFF_RW_DEC) + o); x.d1 = *(const f32x4*)(WSP(float, OFF_RW_DEC) + o + 4);
    x.v = *(const unsigned*)(WSP(bf16_t, OFF_RW_V) + tok * 256 + h * 64 + qtr * 16 + (lt & 7) * 2);
}
__device__ __forceinline__ void rw_put8(LAS unsigned char* p, const u32x4& q) {
    f32x4 v; v[0] = bflo(q[0]); v[1] = bfhi(q[0]); v[2] = bflo(q[1]); v[3] = bfhi(q[1]); *(LAS f32x4*)p = v;
    v[0] = bflo(q[2]); v[1] = bfhi(q[2]); v[2] = bflo(q[3]); v[3] = bfhi(q[3]); *(LAS f32x4*)(p + 16) = v;
}
__device__ __forceinline__ void rw_store8(LAS unsigned char* buf, int lt, const RwLoad8& x) {
    const int t = lt >> 3, c8 = (lt & 7) * 8; LAS unsigned char* p = buf + (t * 64 + c8) * 4;
    rw_put8(p, x.r); *(LAS f32x4*)(p + 8192) = x.d0; *(LAS f32x4*)(p + 8192 + 16) = x.d1; rw_put8(p + 16384, x.k); rw_put8(p + 24576, x.kk); rw_put8(p + 32768, x.b);
    f32x2 vv; vv[0] = bflo(x.v); vv[1] = bfhi(x.v); *(LAS f32x2*)(buf + 40960 + (t * 16 + (lt & 7) * 2) * 4) = vv;
}
__device__ __forceinline__ void rwkv_scan(const Params& P, int task, LAS unsigned char* lds, int tid) {
    const int lane = tid & 63, w = tid >> 6, qtr = task & 3, h = (task >> 2) & 3, b = task >> 4;
    constexpr int RS_Y2 = 2 * RS_BUF;
    if (w >= 4) {
        const int lt = tid - 256;
        RwLoad8 x;
        rw_load8(P, b, h, qtr, 0, lt, x); rw_store8(lds, lt, x);
        __syncthreads();
        for (int ch = 0; ch < 128; ++ch) {
            if (ch + 1 < 128) rw_load8(P, b, h, qtr, ch + 1, lt, x);
            if (ch > 0) {
                const int t = lt >> 3, r2 = (lt & 7) * 2; const size_t tok = (size_t)b * SEQ + (ch - 1) * 32 + t;
                const f32x2 yy = *(const LAS f32x2*)(lds + RS_Y2 + ((ch - 1) & 1) * 2048 + (t * 16 + r2) * 4);
                *(f32x2*)((char*)(P.ws + OFF_PS + 2048) + tok * (PSLD * 2) + (h * 64 + qtr * 16 + r2) * 4) = yy;
            }
            if (ch + 1 < 128) rw_store8(lds + ((ch + 1) & 1) * RS_BUF, lt, x);
            __syncthreads();
        }
        { const int t = lt >> 3, r2 = (lt & 7) * 2; const size_t tok = (size_t)b * SEQ + 127 * 32 + t;
          const f32x2 yy = *(const LAS f32x2*)(lds + RS_Y2 + (127 & 1) * 2048 + (t * 16 + r2) * 4);
          *(f32x2*)((char*)(P.ws + OFF_PS + 2048) + tok * (PSLD * 2) + (h * 64 + qtr * 16 + r2) * 4) = yy; }
    } else {
        const int kq = lane & 15, row = w * 4 + (lane >> 4);
        f32x2 Sa = {0.f, 0.f}, Sb = {0.f, 0.f};
        __syncthreads();
        for (int ch = 0; ch < 128; ++ch) {
            const LAS unsigned char* buf = lds + (ch & 1) * RS_BUF;
            LAS float* Y = (LAS float*)(lds + RS_Y2 + (ch & 1) * 2048);
            RwStep sa_, sb_, sc_; rw_read(buf, 0, kq, row, sa_); rw_read(buf, 1, kq, row, sb_);
#define LO2(v) ((f32x2){(v)[0], (v)[1]})
#define HI2(v) ((f32x2){(v)[2], (v)[3]})
            float p; { f32x2 tp = Sa * LO2(sa_.kk4); tp = Sb * HI2(sa_.kk4) + tp; p = rowsum16(tp[0] + tp[1]); }
#define RW_STEP(cur, nxt, far, tt) do { \
                rw_read(buf, (tt) + 2 < 32 ? (tt) + 2 : 31, kq, row, far); \
                const f32x2 nsa2 = {-p, -p}, vv2 = {cur.vv, cur.vv}; \
                Sa = Sa * LO2(cur.w4) + (nsa2 * LO2(cur.b4) + vv2 * LO2(cur.k4)); Sb = Sb * HI2(cur.w4) + (nsa2 * HI2(cur.b4) + vv2 * HI2(cur.k4)); \
                f32x2 ty = Sa * LO2(cur.r4), tq = Sa * LO2(nxt.kk4); ty = Sb * HI2(cur.r4) + ty; tq = Sb * HI2(nxt.kk4) + tq; \
                float y = ty[0] + ty[1], q = tq[0] + tq[1]; \
                rowsum16x2(y, q); \
                Y[(tt) * 16 + row] = y; \
                p = q; } while (0)
#pragma unroll 1
            for (int t = 0; t < 30; t += 3) { RW_STEP(sa_, sb_, sc_, t); RW_STEP(sb_, sc_, sa_, t + 1); RW_STEP(sc_, sa_, sb_, t + 2); }
            RW_STEP(sa_, sb_, sc_, 30); RW_STEP(sb_, sc_, sa_, 31);
#undef LO2
#undef HI2
#undef RW_STEP
            __syncthreads();
        }
    }
    __syncthreads();
}

__device__ __forceinline__ void rwkv_post(const Params& P, int L, size_t tok, int lane) {
    const int c = lane * 4, hh = lane >> 4;
    const f32x4 y = *(const f32x4*)((const char*)(P.ws + OFF_PS + 2048) + tok * (PSLD * 2) + c * 4);
    const float mean = rowsum16((y[0] + y[1]) + (y[2] + y[3])) * (1.f / 64.f);
    const f32x4 d = y - mean;
    const float var = rowsum16((d[0] * d[0] + d[1] * d[1]) + (d[2] * d[2] + d[3] * d[3])) * (1.f / 64.f);
    const float rstd = rsqrtf(var + GN_EPS);
    const size_t o = tok * 256 + c;
    const u32x2 r2 = *(const u32x2*)(WSP(bf16_t, OFF_RW_R) + o), k2 = *(const u32x2*)(WSP(bf16_t, OFF_RW_K) + o), v2 = *(const u32x2*)(WSP(bf16_t, OFF_RW_V) + o), g2 = *(const u32x2*)(WSP(bf16_t, OFF_RW_G) + o);
    const float r[4] = {bflo(r2[0]), bfhi(r2[0]), bflo(r2[1]), bfhi(r2[1])}, k[4] = {bflo(k2[0]), bfhi(k2[0]), bflo(k2[1]), bfhi(k2[1])},
                v[4] = {bflo(v2[0]), bfhi(v2[0]), bflo(v2[1]), bfhi(v2[1])}, g[4] = {bflo(g2[0]), bfhi(g2[0]), bflo(g2[1]), bfhi(g2[1])};
    const f32x4 rk = *(const f32x4*)(P.in[IRW_RK] + L * 256 + c), lg = *(const f32x4*)(P.in[IRW_LNG] + L * 256 + c), lb = *(const f32x4*)(P.in[IRW_LNB] + L * 256 + c);
    float bs = 0.f;
#pragma unroll
    for (int j = 0; j < 4; ++j) bs += r[j] * k[j] * rk[j];
    bs = rowsum16(bs);
    float o4[4];
#pragma unroll
    for (int j = 0; j < 4; ++j) o4[j] = (d[j] * rstd * lg[j] + lb[j] + bs * v[j]) * g[j];
    u32x2 t; t[0] = pk2(o4[0], o4[1]); t[1] = pk2(o4[2], o4[3]);
    *(u32x2*)(WSP(bf16_t, OFF_YC) + tok * 1024 + 512 + c) = t;
    (void)hh;
}

#define MFMA32(a, b, c) __builtin_amdgcn_mfma_f32_32x32x16_bf16(a, b, c, 0, 0, 0)
struct TileRegs { u32x4 k, v; float bias; };
template <bool SB>
__device__ __forceinline__ void attn_load(const Params& P, size_t tokb, int h, int j, int tid, float coff, const float* clrow, TileRegs& x) {
    const bf16_t* PS = WSP(bf16_t, OFF_PS); constexpr int KC = SB ? 2304 : 512, VC = SB ? 2560 : 768;
    x.k = *(const u32x4*)(PS + (tokb + 64 * j + (tid >> 3)) * PSLD + KC + h * 64 + (tid & 7) * 8);
    x.v = *(const u32x4*)(PS + (tokb + 64 * j + (tid >> 3)) * PSLD + VC + h * 64 + (tid & 7) * 8);
    if (!SB) x.bias = -(coff + clrow[64 * j + (tid & 63)]) * 1.4426950408889634f;
}
template <bool SB>
__device__ __forceinline__ void attn_store(LAS unsigned char* lds, int buf, int tid, const TileRegs& x) {
    *(LAS u32x4*)(lds + buf * 9216 + ((tid >> 3) * 72 + (tid & 7) * 8) * 2) = x.k;
    *(LAS u32x4*)(lds + 18432 + buf * 9216 + ((tid >> 3) * 72 + (tid & 7) * 8) * 2) = x.v;
    if (!SB) { if (tid < 64) *(LAS float*)(lds + 36864 + buf * 256 + tid * 4) = x.bias; }
}
template <bool SB>
__device__ __forceinline__ void attn_unit(const Params& P, int b, int h, int qb, LAS unsigned char* lds, int tid) {
    const int lane = tid & 63, r32 = lane & 31, hi = lane >> 5, w = tid >> 6;
    const size_t tokb = (size_t)b * SEQ; const int q0 = qb * 256, qw0 = q0 + 32 * w, qpos = qw0 + r32, jd = qw0 >> 6;
    const bf16_t* PS = WSP(bf16_t, OFF_PS); constexpr int QC = SB ? 2048 : 256, OC = SB ? 768 : 256;
    const float* clrow = WSP(float, OFF_CL) + ((size_t)b * 4 + h) * SEQ;
    bf16x8 qr[4];
#pragma unroll
    for (int d0 = 0; d0 < 4; ++d0) qr[d0] = *(const bf16x8*)(PS + (tokb + qpos) * PSLD + QC + h * 64 + d0 * 16 + hi * 8);
    f32x16 O0, O1;
#pragma unroll
    for (int r = 0; r < 16; ++r) { O0[r] = 0.f; O1[r] = 0.f; }
    float mrun = -INFINITY, lrun = 0.f, Rrun = 0.f, coff = 0.f;
    const int NT = 4 * qb + 4;
    TileRegs x;
    { const int j = SB ? NT - 1 : 0; attn_load<SB>(P, tokb, h, j, tid, coff, clrow, x); attn_store<SB>(lds, 0, tid, x); if (!SB) coff += clrow[64 * j + 63]; }
    __syncthreads();
    for (int it = 0; it < NT; ++it) {
        const int j = SB ? NT - 1 - it : it, buf = it & 1; const bool more = it + 1 < NT;
        if (more) { const int jn = SB ? j - 1 : j + 1; attn_load<SB>(P, tokb, h, jn, tid, coff, clrow, x); if (!SB) coff += clrow[64 * jn + 63]; }
        if (j <= jd) {
            const LAS bf16_t* Ks = (const LAS bf16_t*)(lds + buf * 9216); const LAS bf16_t* Vt = (const LAS bf16_t*)(lds + 18432 + buf * 9216);
            f32x16 p0, p1;
            if (!SB) {
                const LAS float* bs0 = (const LAS float*)(lds + 36864 + buf * 256);
#pragma unroll
                for (int rq = 0; rq < 4; ++rq) { const f32x4 b0 = *(const LAS f32x4*)(bs0 + 8 * rq + 4 * hi), b1 = *(const LAS f32x4*)(bs0 + 32 + 8 * rq + 4 * hi);
#pragma unroll
                    for (int i = 0; i < 4; ++i) { p0[4 * rq + i] = b0[i]; p1[4 * rq + i] = b1[i]; } }
            } else {
#pragma unroll
                for (int r = 0; r < 16; ++r) { p0[r] = 0.f; p1[r] = 0.f; }
            }
            __builtin_amdgcn_s_setprio(1);
#pragma unroll
            for (int d0 = 0; d0 < 4; ++d0) {
                const bf16x8 a0 = *(const LAS bf16x8*)(Ks + r32 * 72 + d0 * 16 + hi * 8), a1 = *(const LAS bf16x8*)(Ks + (32 + r32) * 72 + d0 * 16 + hi * 8);
                p0 = MFMA32(a0, qr[d0], p0); p1 = MFMA32(a1, qr[d0], p1);
            }
            __builtin_amdgcn_s_setprio(0);
            const int kbase = 64 * j + 4 * hi;
            bf16x8 pf[4];
            if (!SB) {
                float mt = -INFINITY;
                if (j == jd) {
#pragma unroll
                    for (int rq = 0; rq < 4; ++rq)
#pragma unroll
                        for (int i = 0; i < 4; ++i) { const int r = 4 * rq + i; const int kp = kbase + i + 8 * rq;
                            if (kp > qpos) p0[r] = -INFINITY; if (kp + 32 > qpos) p1[r] = -INFINITY; }
                }
#pragma unroll
                for (int r = 0; r < 16; ++r) mt = fmaxf(mt, fmaxf(p0[r], p1[r]));
                mt = fmaxf(mt, other_half(mt, hi));
                const float mnew = fmaxf(mrun, mt), alpha = __builtin_amdgcn_exp2f(mrun - mnew); mrun = mnew;
                float ls = 0.f;
#pragma unroll
                for (int r = 0; r < 16; ++r) { p0[r] = __builtin_amdgcn_exp2f(p0[r] - mnew); p1[r] = __builtin_amdgcn_exp2f(p1[r] - mnew); ls += p0[r] + p1[r]; }
                lrun = lrun * alpha + ls;
#pragma unroll
                for (int r = 0; r < 16; ++r) { O0[r] *= alpha; O1[r] *= alpha; }
            } else {
                float gs[2][4], og[2][4]; f32x16 lr0, lr1;
#pragma unroll
                for (int rq = 0; rq < 4; ++rq) { float g0 = 0.f, g1 = 0.f;
#pragma unroll
                    for (int i = 0; i < 4; ++i) { const int r = 4 * rq + i; const int kp = kbase + i + 8 * rq;
                        const float z0 = p0[r], z1 = p1[r];
                        const float sp0 = fmaxf(z0, 0.f) + __builtin_amdgcn_logf(1.f + __builtin_amdgcn_exp2f(-fabsf(z0))), sp1 = fmaxf(z1, 0.f) + __builtin_amdgcn_logf(1.f + __builtin_amdgcn_exp2f(-fabsf(z1)));
                        const bool in0 = kp < qpos, in1 = kp + 32 < qpos;
                        lr0[r] = in0 ? -sp0 : 0.f; lr1[r] = in1 ? -sp1 : 0.f;
                        p0[r] = in0 ? z0 - sp0 : -INFINITY; p1[r] = in1 ? z1 - sp1 : -INFINITY;
                        g0 += lr0[r]; g1 += lr1[r]; }
                    gs[0][rq] = g0; gs[1][rq] = g1; }
#pragma unroll
                for (int kb = 0; kb < 2; ++kb)
#pragma unroll
                    for (int rq = 0; rq < 4; ++rq) og[kb][rq] = other_half(gs[kb][rq], hi);
                float T = 0.f;
#pragma unroll
                for (int kb = 1; kb >= 0; --kb)
#pragma unroll
                    for (int rq = 3; rq >= 0; --rq) {
                        float run = Rrun + T + (hi == 0 ? og[kb][rq] : 0.f);
#pragma unroll
                        for (int i = 3; i >= 0; --i) { const int r = 4 * rq + i;
                            if (kb) { const float wgt = __builtin_amdgcn_exp2f(p1[r] + run); run += lr1[r]; p1[r] = wgt; }
                            else { const float wgt = __builtin_amdgcn_exp2f(p0[r] + run); run += lr0[r]; p0[r] = wgt; } }
                        T += gs[kb][rq] + og[kb][rq];
                    }
                Rrun += T;
            }
#pragma unroll
            for (int ks = 0; ks < 4; ++ks) { u32x4 o;
#pragma unroll
                for (int i = 0; i < 4; ++i) { const int r = 8 * (ks & 1) + 2 * i; o[i] = (ks >> 1) ? pk2(p1[r], p1[r + 1]) : pk2(p0[r], p0[r + 1]); }
                pf[ks] = __builtin_bit_cast(bf16x8, o); }
#pragma unroll
            for (int ks = 0; ks < 4; ++ks) {
                const LAS bf16_t* vb = Vt + (16 * ks + 4 * hi + ((lane & 15) >> 2)) * 72 + 16 * ((lane >> 4) & 1) + 4 * (lane & 3);
                const s16x4 v0a = __builtin_amdgcn_ds_read_tr16_b64_v4i16((LAS s16x4*)(vb)), v0b = __builtin_amdgcn_ds_read_tr16_b64_v4i16((LAS s16x4*)(vb + 8 * 72));
                const s16x4 v1a = __builtin_amdgcn_ds_read_tr16_b64_v4i16((LAS s16x4*)(vb + 32)), v1b = __builtin_amdgcn_ds_read_tr16_b64_v4i16((LAS s16x4*)(vb + 8 * 72 + 32));
                bf16x8 a0, a1;
#pragma unroll
                for (int e = 0; e < 4; ++e) { a0[e] = v0a[e]; a0[4 + e] = v0b[e]; a1[e] = v1a[e]; a1[4 + e] = v1b[e]; }
                __builtin_amdgcn_s_setprio(1); O0 = MFMA32(a0, pf[ks], O0); O1 = MFMA32(a1, pf[ks], O1); __builtin_amdgcn_s_setprio(0);
            }
        }
        if (more) attn_store<SB>(lds, buf ^ 1, tid, x);
        if (SB) {
            const bool wdone = __builtin_amdgcn_ballot_w64((j <= jd) && (Rrun < -160.f)) == ~0ull;
            LAS unsigned* votes = (LAS unsigned*)(lds + 37376) + (it & 1) * 8;
            if (lane == 0) votes[w] = wdone ? 1u : 0u;
            __syncthreads();
            const u32x4 va = *(const LAS u32x4*)votes, vb = *(const LAS u32x4*)(votes + 4);
            if ((va[0] & va[1] & va[2] & va[3] & vb[0] & vb[1] & vb[2] & vb[3]) != 0u) break;
        }
        else __syncthreads();
    }
    if (!SB) { const float lt = lrun + other_half(lrun, hi); const float inv = 1.f / lt;
#pragma unroll
        for (int r = 0; r < 16; ++r) { O0[r] *= inv; O1[r] *= inv; } }
    bf16_t* orow = WSP(bf16_t, OFF_YC) + (tokb + qpos) * 1024 + OC + h * 64 + 4 * hi;
#pragma unroll
    for (int rq = 0; rq < 4; ++rq) {
        u32x2 t0; t0[0] = pk2(O0[4 * rq], O0[4 * rq + 1]); t0[1] = pk2(O0[4 * rq + 2], O0[4 * rq + 3]); *(u32x2*)(orow + 8 * rq) = t0;
        u32x2 t1; t1[0] = pk2(O1[4 * rq], O1[4 * rq + 1]); t1[1] = pk2(O1[4 * rq + 2], O1[4 * rq + 3]); *(u32x2*)(orow + 32 + 8 * rq) = t1;
    }
    __syncthreads();
}

#define XB_TMO      128
#define XB_XCNT(j)  (256  + 64 * (j))
#define XB_XSUB(j)  (1280 + 64 * (j))
#define XB_XGEN(j)  (2304 + 64 * (j))
#define XB_TOP      3328
#define XB_TOPGEN   3392
#define XCD_BAR_WORDS 3456
#define XB_SPIN_CAP (1u << 18)
__device__ __forceinline__ unsigned xb_ld(unsigned* p)              { return __hip_atomic_load(p, __ATOMIC_RELAXED, __HIP_MEMORY_SCOPE_AGENT); }
__device__ __forceinline__ unsigned xb_add(unsigned* p, unsigned v) { return __hip_atomic_fetch_add(p, v, __ATOMIC_RELAXED, __HIP_MEMORY_SCOPE_AGENT); }
__device__ __forceinline__ unsigned xb_xcc_id() { return (unsigned)__builtin_amdgcn_s_getreg((3 << 11) | 20) & 0xFu; }
#define XB_SPIN(cond, bar) do { unsigned _sp = 0; while (cond) { __builtin_amdgcn_s_sleep(1); \
    if ((++_sp & 255u) == 0u) { if (xb_ld(&(bar)[XB_TMO])) break; if (_sp > XB_SPIN_CAP) { atomicAdd(&(bar)[XB_TMO], 1u); break; } } } } while (0)
struct XcdBarrier { unsigned* bar; unsigned x; volatile LAS unsigned* st; };
__device__ __forceinline__ XcdBarrier xcd_barrier_post(unsigned* bar, volatile LAS unsigned* st) {
    XcdBarrier b; b.bar = bar; b.x = xb_xcc_id(); b.st = st;
    if (threadIdx.x == 0) (void)xb_add(&bar[XB_XCNT(b.x)], 1u);
    return b;
}
__device__ __forceinline__ void xcd_barrier_complete(unsigned* bar, unsigned x, unsigned& nloc, unsigned& nx) {
    const unsigned G = gridDim.x * gridDim.y * gridDim.z;
    unsigned sum, cnt, mine, sp = 0u;
    for (;;) {
        sum = 0u; cnt = 0u; mine = 0u;
#pragma unroll
        for (unsigned j = 0; j < 16; ++j) { const unsigned c = xb_ld(&bar[XB_XCNT(j)]); sum += c; cnt += (c > 0u) ? 1u : 0u; mine = (j == x) ? c : mine; }
        if (sum == G) break;
        __builtin_amdgcn_s_sleep(1);
        if ((++sp & 255u) == 0u) { if (xb_ld(&bar[XB_TMO])) break; if (sp > XB_SPIN_CAP) { atomicAdd(&bar[XB_TMO], 1u); break; } }
    }
    nloc = mine > 0u ? mine : 1u; nx = cnt > 0u ? cnt : 1u;
}
__device__ __forceinline__ void xcd_barrier(const XcdBarrier& b) {
    asm volatile("s_waitcnt vmcnt(0)" ::: "memory");
    __syncthreads();
    if (threadIdx.x == 0) {
        unsigned* bar = b.bar;
        __builtin_amdgcn_s_waitcnt(0);
        unsigned nloc = b.st[0], nx = b.st[1];
        if (nloc == 0u) { xcd_barrier_complete(bar, b.x, nloc, nx); b.st[0] = nloc; b.st[1] = nx; }
        const unsigned old = xb_add(&bar[XB_XSUB(b.x)], 1u);
        const unsigned gen = old / nloc;
        if (old + 1u == (gen + 1u) * nloc) {
            __builtin_amdgcn_fence(__ATOMIC_RELEASE, "agent");
            asm volatile("s_waitcnt vmcnt(0)" ::: "memory");
            const unsigned og = xb_add(&bar[XB_TOP], 1u);
            const unsigned tg = og / nx;
            if (og + 1u == (tg + 1u) * nx) xb_add(&bar[XB_TOPGEN], 1u);
            else XB_SPIN(xb_ld(&bar[XB_TOPGEN]) == tg, bar);
            __builtin_amdgcn_fence(__ATOMIC_ACQUIRE, "agent");
            xb_add(&bar[XB_XGEN(b.x)], 1u);
            asm volatile("s_waitcnt vmcnt(0)" ::: "memory");
        } else {
            XB_SPIN(xb_ld(&bar[XB_XGEN(b.x)]) == gen, bar);
            __builtin_amdgcn_fence(__ATOMIC_ACQUIRE, "agent");
            asm volatile("s_waitcnt vmcnt(0)" ::: "memory");
        }
    }
    __syncthreads();
}

#ifndef REP_K
#define REP_K -2
#endif
#ifndef MK_LAUNCHES
#define MK_LAUNCHES 1
#endif
__global__ void __launch_bounds__(512, 2) fwd_megakernel(Params P0, int ph_lo, int ph_hi) {
    extern __shared__ __attribute__((aligned(16))) unsigned char smem[];
    __shared__ int s_task;
    __shared__ unsigned xb_st[2];
    LAS unsigned char* lds = (LAS unsigned char*)smem;
    const int wave0 = __builtin_amdgcn_readfirstlane(threadIdx.x >> 6), G = gridDim.x, c = blockIdx.x, NGW = G * 8;
    __builtin_assume(G >= 1 && G <= 256 && c >= 0 && c < 256);
    if (threadIdx.x == 0) { xb_st[0] = 0u; xb_st[1] = 0u; }
    __syncthreads();
    const XcdBarrier xb = xcd_barrier_post((unsigned*)(P0.ws + OFF_BAR), (volatile LAS unsigned*)xb_st);
#define TID() ({ int t_ = (int)__builtin_amdgcn_mbcnt_hi(~0u, __builtin_amdgcn_mbcnt_lo(~0u, 0u)); asm volatile("" : "+v"(t_)); t_ | (wave0 << 6); })
#define PHASE_IDS() const int tid = TID(), lane = tid & 63, wave = tid >> 6, gw = c * 8 + wave; (void)lane; (void)gw
#pragma unroll 1
    for (int phx = ph_lo * 2; phx < ph_hi * 2; ++phx) {
        const Params& P = P0;
        unsigned* ctr = WSP(unsigned, OFF_CTR);
        const int ph = phx >> 1, rep = phx & 1;
        const int L = ph == 0 ? 0 : (ph - 1) / 10, k = ph == 0 ? -1 : (ph - 1) % 10;
        if (rep == 1 && k != REP_K) continue;
        if (ph == 0) {
            PHASE_IDS();
            if (c == 0 && tid < 64) ctr[tid] = 0u;
            for (int t = c; t < WCONV_TASKS; t += G) wconv_task(P, 0, t, (LAS float*)lds, tid);
            for (int t = c; t < MTOK * 1024 / 16384; t += G) cvt_task4(P.in[IX], WSP(bf16_t, OFF_HB), t, tid);
        } else if (k == 0) {
#ifndef NO_G1
            SchedG1 S{P, G, c}; EpiG1 E{P}; pg8::gemm_phase(lds, S, E, TID());
#endif
        } else if (k == 1) {
            PHASE_IDS();
#ifndef NO_PREP
            for (int t = c; t < MTOK / 32; t += G) rwkv_prep(P, L, t, lds, tid);
#endif
#ifndef NO_S51
            for (int t = gw; t < NB * 16 * 16; t += NGW) s5_pass1(P, L, t, lane);
#endif
            for (int t = gw; t < NB * 64; t += NGW) cl_task(P, L, t, lane);
        } else if (k == 2) {
            PHASE_IDS();
            for (;;) {
                if (tid == 0) s_task = (int)atomicAdd(ctr + L * 2 + rep, 1u);
                __syncthreads();
                int t = s_task;
                __syncthreads();
                if (t >= 128 + 512 + 256 + 512) break;
                { const int a_ = t - 128; if (a_ >= 224 && a_ < 224 + 256) t = 128 + 512 + (a_ - 224); else if (a_ >= 224 + 256 && a_ < 512 + 256) t = 128 + 224 + (a_ - 224 - 256); }
#ifdef REP_MASK
                if (rep == 1) { const int cls = t < 128 ? 1 : t < 128 + 512 ? 2 : t < 128 + 512 + 256 ? 4 : 8; if (!(cls & REP_MASK)) continue; }
#endif
#ifndef NO_SCAN
                if (t < 128) rwkv_scan(P, t, lds, tid); else
#endif
#ifndef NO_FOX
                if (t < 128 + 512) { const int i = t - 128; attn_unit<false>(P, (i & 31) >> 2, i & 3, 15 - (i >> 5), lds, tid); } else
#endif
#ifndef NO_S53
                if (t < 128 + 512 + 256) s5_pass3(P, L, t - (128 + 512), lds, tid); else
#endif
#ifndef NO_SB
                { const int i = t - (128 + 512 + 256); attn_unit<true>(P, (i & 31) >> 2, i & 3, 15 - (i >> 5), lds, tid); }
#else
                {}
#endif
            }
        } else if (k == 3) {
            PHASE_IDS(); for (int tok = gw; tok < MTOK; tok += NGW) rwkv_post(P, L, (size_t)tok, lane);
        } else if (k == 4) {
#ifndef NO_G2
            SchedG2 S{P, G, c}; EpiG2 E{P}; pg8::gemm_phase(lds, S, E, TID());
#endif
        } else if (k == 5) {
#ifndef NO_G3
            SchedG3 S{P, G, c}; EpiG3 E{P, L == 0 ? P.in[IX] : (const float*)P.out, L == 0 ? (const float*)nullptr : P.in[ILN2G] + (L - 1) * 1024, L == 0 ? (const float*)nullptr : P.in[ILN2B] + (L - 1) * 1024}; pg8::gemm_phase(lds, S, E, TID());
#endif
        } else if (k == 6) {
            PHASE_IDS();
            for (int r = gw * 4; r < MTOK; r += NGW * 4) ln_rows4(P.out + (size_t)r * 1024, P.in[ILN1G] + L * 1024, P.in[ILN1B] + L * 1024, WSP(bf16_t, OFF_HB) + (size_t)r * 1024, WSP(f32x2, OFF_STAT) + r, false, lane);
            for (int t = c; t < MTOK * 256 / 16384; t += G) cvt_task4(P.in[IP] + (size_t)L * MTOK * 256, WSP(bf16_t, OFF_YC), t, tid);
        } else if (k == 7) {
#ifndef NO_G4
            SchedG4 S{P, G, c}; EpiG4 E{P}; pg8::gemm_phase(lds, S, E, TID());
#endif
        } else if (k == 8) {
#ifndef NO_G5
            SchedG5 S{P, G, c}; EpiG5 E{P, P.in[ILN1G] + L * 1024, P.in[ILN1B] + L * 1024}; pg8::gemm_phase(lds, S, E, TID());
#endif
        } else {
            PHASE_IDS();
            for (int r = gw * 4; r < MTOK; r += NGW * 4) ln_rows4(P.out + (size_t)r * 1024, P.in[ILN2G] + L * 1024, P.in[ILN2B] + L * 1024, L + 1 < DEPTH ? WSP(bf16_t, OFF_HB) + (size_t)r * 1024 : (bf16_t*)nullptr, L + 1 < DEPTH ? WSP(f32x2, OFF_STAT) + r : (f32x2*)nullptr, L + 1 == DEPTH, lane);
            if (L + 1 < DEPTH) { for (int t = c; t < WCONV_TASKS; t += G) wconv_task(P, L + 1, t, (LAS float*)lds, tid); }
        }
        if (phx + 1 < ph_hi * 2) { if (ph_lo < 0) cg::this_grid().sync(); else xcd_barrier(xb); }
    }
}
constexpr int N_PHASES = 1 + 10 * DEPTH;

#ifdef PROBE_PH
__global__ void probe_dump(Params P, int mode) {
    const size_t i = (size_t)blockIdx.x * blockDim.x + threadIdx.x; if (i >= (size_t)MTOK * 1024) return;
    const size_t tok = i >> 10; const int c = (int)(i & 1023);
    float v = 0.f;
    if (mode == 0) { v = bf1(WSP(bf16_t, OFF_PS)[tok * PSLD + c]); }
    else if (mode == 1) { v = bf1(WSP(bf16_t, OFF_PS)[tok * PSLD + 1024 + 768 + c]); if (c >= 1024 - 0) v = 0.f; }
    else if (mode == 2) { v = (c >= 512 && c < 768) ? 0.f : bf1(WSP(bf16_t, OFF_YC)[tok * 1024 + c]); }
    else if (mode == 3) { v = bf1(WSP(bf16_t, OFF_YC)[tok * 1024 + c]); }
    else if (mode == 4) { v = bf1(WSP(bf16_t, OFF_MG)[tok * 1024 + c]); }
    else if (mode == 5) { v = c < 256 ? WSP(float, OFF_RW_DEC)[tok * 256 + c] : c < 512 ? bf1(WSP(bf16_t, OFF_RW_KK)[tok * 256 + c - 256]) : c < 768 ? bf1(WSP(bf16_t, OFF_RW_B)[tok * 256 + c - 512]) : bf1(WSP(bf16_t, OFF_RW_G)[tok * 256 + c - 768]); }
    else if (mode == 6) { v = c < 256 ? ((const float*)(P.ws + OFF_PS + 2048 + tok * (PSLD * 2)))[c] : 0.f; }
    else if (mode == 7) { v = P.out[i]; }
    else if (mode == 10) { v = c < 256 ? bf1(WSP(bf16_t, OFF_RW_KK)[tok * 256 + c]) : c < 512 ? bf1(WSP(bf16_t, OFF_RW_V)[tok * 256 + c - 256]) : c < 768 ? bf1(WSP(bf16_t, OFF_RW_R)[tok * 256 + c - 512]) : 0.f; }
    else if (mode == 12) { v = c < 768 ? bf1(WSP(bf16_t, OFF_YC)[tok * 1024 + c]) : bf1(WTP(WT_RW2)[(i >> 2) & 65535]); }
    else if (mode == 13) { v = c < 256 ? WSP(float, OFF_RW_DEC)[tok * 256 + c] : 0.f; }
    else if (mode == 14) { v = c < 256 ? bf1(WSP(bf16_t, OFF_RW_B)[tok * 256 + c]) : c < 512 ? bf1(WSP(bf16_t, OFF_RW_G)[tok * 256 + c - 256]) : c < 768 ? bf1(WSP(bf16_t, OFF_RW_K)[tok * 256 + c - 512]) : 0.f; }
    else if (mode == 8) { v = bf1(WSP(bf16_t, OFF_PS)[tok * PSLD + 1024 + c]); }
    else if (mode == 9) { v = c < 256 ? bf1(WSP(bf16_t, OFF_RW_R)[tok * 256 + c]) : c < 512 ? bf1(WSP(bf16_t, OFF_RW_K)[tok * 256 + c - 256]) : c < 768 ? bf1(WSP(bf16_t, OFF_RW_V)[tok * 256 + c - 512]) : WSP(float, OFF_RW_DEC)[tok * 256 + c - 768]; }
    P.out[i] = v;
}
#endif
extern "C" void kernel_launch(void* const* d_in, const int* in_sizes, int n_in, void* d_out, int out_size, void* d_ws, size_t ws_size, hipStream_t stream) {
    static int grid = 0;
    if (grid == 0) {
        if (n_in != NIN || out_size != MTOK * 1024 || ws_size < WS_END) { fprintf(stderr, "kernel_launch: unexpected shapes: n_in %d out %d ws %zu (need %zu)\n", n_in, out_size, ws_size, (size_t)WS_END); grid = -1; return; }
        int dev = 0, cus = 0, per_cu = 0;
        (void)hipGetDevice(&dev); (void)hipDeviceGetAttribute(&cus, hipDeviceAttributeMultiprocessorCount, dev);
        if (hipFuncSetAttribute((const void*)fwd_megakernel, hipFuncAttributeMaxDynamicSharedMemorySize, LDS_BYTES) != hipSuccess) { fprintf(stderr, "kernel_launch: hipFuncSetAttribute failed\n"); grid = -1; return; }
        if (hipOccupancyMaxActiveBlocksPerMultiprocessor(&per_cu, (const void*)fwd_megakernel, 512, LDS_BYTES) != hipSuccess || per_cu < 1) { fprintf(stderr, "kernel_launch: occupancy query says %d\n", per_cu); per_cu = 1; }
        (void)hipGetLastError();
        grid = cus * per_cu; if (grid > 256) grid = 256;
        if (grid < 1) grid = -1;
    }
    if (grid < 0) return;
    if (hipMemsetAsync((char*)d_ws + OFF_CTR, 0, 4096 + 16384, stream) != hipSuccess) { fprintf(stderr, "kernel_launch: memset of control words failed\n"); return; }
    Params p{};
    for (int i = 0; i < NIN; ++i) p.in[i] = (const float*)d_in[i];
    p.out = (float*)d_out; p.ws = (unsigned char*)d_ws;
#if MK_LAUNCHES == 1
    int lo = 0, hi = N_PHASES;
    void* args[] = {&p, &lo, &hi};
    hipError_t e = hipLaunchCooperativeKernel((const void*)fwd_megakernel, dim3(grid), dim3(512), args, LDS_BYTES, stream);
    if (e != hipSuccess) fprintf(stderr, "cooperative launch failed: %s (grid %d)\n", hipGetErrorString(e), grid);
#else
#ifdef PROBE_PH
    for (int ph = 0; ph < PROBE_PH; ++ph) hipLaunchKernelGGL(fwd_megakernel, dim3(grid), dim3(512), LDS_BYTES, stream, p, ph, ph + 1);
    hipLaunchKernelGGL(probe_dump, dim3(MTOK * 1024 / 256), dim3(256), 0, stream, p, PROBE_MODE);
#else
    for (int ph = 0; ph < N_PHASES; ++ph) hipLaunchKernelGGL(fwd_megakernel, dim3(grid), dim3(512), LDS_BYTES, stream, p, ph, ph + 1);
#endif
#endif
}
```
